# Optimizing an MI355X kernel written in HIP

```python
import math
import jax, jax.numpy as jnp
from jax import lax
import numpy as np

D_MODEL = 2048
BATCH = 4
SEQ = 2048
DEPTH = 1

D_SSM = D_MODEL // 2
D_ATTN = D_MODEL - D_SSM
SSM_CH = 16
SSM_GROUPS = D_SSM // SSM_CH
SSM_STATE = 64
ATTN_HEAD_DIM = 64
N_HEADS = D_ATTN // ATTN_HEAD_DIM
DILATED_PATTERNS = ((128, 1), (512, 4), (2048, 16))
ATTN_BLOCK = 128
N_EXPERTS = 64
TOP_K = 8
N_EXPERT_GROUPS = 8
TOPK_GROUPS = 4
D_EXPERT = 512
ROUTED_SCALE = 2.5
MOE_BLOCK = 128
DT_MIN = 0.001
DT_MAX = 0.1
NORM_EPS = 1e-5
DEEPNORM_ALPHA = (2.0 * DEPTH) ** 0.25
DEEPNORM_BETA = (8.0 * DEPTH) ** -0.25

kernel_name = 'hymba_s5_longnet_alibi_deepnorm_moe'


def _layer_norm(x, g, b):
    xf = x.astype(jnp.float32)
    mu = jnp.mean(xf, axis=-1, keepdims=True)
    var = jnp.mean(jnp.square(xf - mu), axis=-1, keepdims=True)
    return ((xf - mu) * lax.rsqrt(var + NORM_EPS) * g.astype(jnp.float32) + b.astype(jnp.float32)).astype(x.dtype)


def _rms_norm(x, g):
    xf = x.astype(jnp.float32)
    return (xf * lax.rsqrt(jnp.mean(jnp.square(xf), axis=-1, keepdims=True) + NORM_EPS) * g.astype(jnp.float32)).astype(x.dtype)


def _s5_mixer(u, log_dt, a_re, a_im, b_re, b_im, c_re, c_im, d_skip, w_glu):
    bsz, seq, _ = u.shape
    f32 = jnp.float32
    uf = u.astype(f32).reshape(bsz, seq, SSM_GROUPS, SSM_CH)
    lam = lax.complex(jnp.minimum(a_re.astype(f32), -1e-4), a_im.astype(f32))
    dt = jnp.exp(log_dt.astype(f32))
    a_bar = jnp.exp(lam * dt)
    b_c = lax.complex(b_re.astype(f32), b_im.astype(f32))
    b_bar = ((a_bar - 1.0) / lam)[..., None] * b_c
    bu = jnp.einsum('bsgc,gpc->bsgp', uf.astype(jnp.complex64), b_bar)
    a_seq = jnp.broadcast_to(a_bar, (1, seq, SSM_GROUPS, SSM_STATE))

    def combine(e1, e2):
        a1, b1 = e1
        a2, b2 = e2
        return a2 * a1, a2 * b1 + b2

    _, h = lax.associative_scan(combine, (a_seq, bu), axis=1)
    c_c = lax.complex(c_re.astype(f32), c_im.astype(f32))
    y = jnp.einsum('bsgp,gcp->bsgc', h, c_c).real + d_skip.astype(f32) * uf
    y = y.reshape(bsz, seq, D_SSM).astype(u.dtype)
    z = jax.nn.gelu(y) @ w_glu
    val, gate = jnp.split(z, 2, axis=-1)
    return val * jax.nn.sigmoid(gate)


def _dilated_window_attention(q, k, v, slopes, window, dilation):
    bsz, seq, n_h, dh = q.shape
    steps = window // dilation
    sub_len = seq // dilation
    nb = -(-sub_len // ATTN_BLOCK)
    sub_pad = nb * ATTN_BLOCK

    def to_sub(t):
        t = t.reshape(bsz, sub_len, dilation, n_h, dh).transpose(0, 2, 3, 1, 4)
        t = jnp.pad(t, ((0, 0), (0, 0), (0, 0), (0, sub_pad - sub_len), (0, 0)))
        return t.reshape(bsz, dilation, n_h, nb, ATTN_BLOCK, dh)

    def with_prev(t):
        prev = jnp.pad(t[:, :, :, :-1], ((0, 0), (0, 0), (0, 0), (1, 0), (0, 0), (0, 0)))
        return jnp.concatenate([prev, t], axis=4)

    qb = to_sub(q)
    kk = with_prev(to_sub(k))
    vv = with_prev(to_sub(v))
    s = jnp.einsum('bdhnqc,bdhnkc->bdhnqk', qb, kk) * (dh ** -0.5)
    blk_ids = jnp.arange(nb)[:, None, None] * ATTN_BLOCK
    q_idx = blk_ids + jnp.arange(ATTN_BLOCK)[None, :, None]
    k_idx = blk_ids - ATTN_BLOCK + jnp.arange(2 * ATTN_BLOCK)[None, None, :]
    delta = q_idx - k_idx
    valid = (delta >= 0) & (delta <= steps) & (k_idx >= 0)
    dist = (delta * dilation).astype(jnp.float32)
    alibi = -slopes[:, None, None, None] * dist
    s = jnp.where(valid, s + alibi, -jnp.inf)
    lse = jax.nn.logsumexp(s, axis=-1)
    o = jnp.einsum('bdhnqk,bdhnkc->bdhnqc', jnp.exp(s - lse[..., None]), vv)

    def from_sub(t, tail):
        t = t.reshape((bsz, dilation, n_h, sub_pad) + tail)[:, :, :, :sub_len]
        t = jnp.moveaxis(t, 3, 1)
        return t.reshape((bsz, seq, n_h) + tail)

    return from_sub(o, (dh,)), from_sub(lse, ())


def _attention_mixer(q, k, v, slopes):
    bsz, seq, _ = q.shape
    shp = (bsz, seq, N_HEADS, ATTN_HEAD_DIM)
    qf, kf, vf = (t.astype(jnp.float32).reshape(shp) for t in (q, k, v))
    outs, lses = [], []
    for window, dilation in DILATED_PATTERNS:
        o, l = _dilated_window_attention(qf, kf, vf, slopes, window, dilation)
        outs.append(o)
        lses.append(l)
    wts = jax.nn.softmax(jnp.stack(lses), axis=0)
    out = jnp.sum(wts[..., None] * jnp.stack(outs), axis=0)
    return out.reshape(bsz, seq, D_ATTN).astype(q.dtype)


def _moe(h, w_router, router_bias, w_gate, w_up, w_down, ws_gate, ws_up, ws_down):
    bsz, seq, d = h.shape
    n_tok = bsz * seq
    xf = h.reshape(n_tok, d)
    scores = jax.nn.sigmoid(xf.astype(jnp.float32) @ w_router.astype(jnp.float32))
    sel = scores + router_bias.astype(jnp.float32)
    grouped = sel.reshape(n_tok, N_EXPERT_GROUPS, N_EXPERTS // N_EXPERT_GROUPS)
    group_score = jnp.sum(lax.top_k(grouped, 2)[0], axis=-1)
    _, top_groups = lax.top_k(group_score, TOPK_GROUPS)
    group_keep = jnp.any(top_groups[..., None] == jnp.arange(N_EXPERT_GROUPS), axis=1)
    expert_keep = jnp.repeat(group_keep, N_EXPERTS // N_EXPERT_GROUPS, axis=1)
    _, top_idx = lax.top_k(jnp.where(expert_keep, sel, -jnp.inf), TOP_K)
    top_w = jnp.take_along_axis(scores, top_idx, axis=1)
    top_w = top_w / jnp.sum(top_w, axis=-1, keepdims=True) * ROUTED_SCALE

    nk = n_tok * TOP_K
    flat_e = top_idx.reshape(nk)
    flat_tok = jnp.repeat(jnp.arange(n_tok, dtype=jnp.int32), TOP_K)
    flat_w = top_w.reshape(nk)
    order = jnp.argsort(flat_e)
    se, stok, sw = flat_e[order], flat_tok[order], flat_w[order]
    counts = jnp.bincount(flat_e, length=N_EXPERTS)
    padded = (counts + MOE_BLOCK - 1) // MOE_BLOCK * MOE_BLOCK
    pad_end = jnp.cumsum(padded)
    pad_start = pad_end - padded
    start = jnp.cumsum(counts) - counts
    dest = pad_start[se] + jnp.arange(nk) - start[se]
    n_blocks = -(-(nk + N_EXPERTS * (MOE_BLOCK - 1)) // MOE_BLOCK)
    n_rows = n_blocks * MOE_BLOCK
    row_tok = jnp.zeros((n_rows,), jnp.int32).at[dest].set(stok)
    row_w = jnp.zeros((n_rows,), jnp.float32).at[dest].set(sw)
    block_e = jnp.minimum(jnp.searchsorted(pad_end, jnp.arange(n_blocks) * MOE_BLOCK, side='right'), N_EXPERTS - 1)

    def expert_block(args):
        tok_blk, e, w_blk = args
        xb = xf[tok_blk]
        yb = (jax.nn.silu(xb @ w_gate[e]) * (xb @ w_up[e])) @ w_down[e]
        return yb * w_blk[:, None].astype(yb.dtype)

    yb = lax.map(expert_block, (row_tok.reshape(n_blocks, MOE_BLOCK), block_e, row_w.reshape(n_blocks, MOE_BLOCK)))
    routed = jax.ops.segment_sum(yb.reshape(n_rows, d), row_tok, num_segments=n_tok)
    shared = (jax.nn.silu(xf @ ws_gate) * (xf @ ws_up)) @ ws_down
    return (routed + shared).reshape(bsz, seq, d)


def setup_inputs(seed: int = 0) -> dict:
    key = jax.random.key(seed)
    ks = jax.random.split(key, 32)
    L = DEPTH
    f32 = jnp.float32

    def nrm(k, shape, scale):
        return jax.random.normal(k, shape, f32) * scale

    x = nrm(ks[0], (BATCH, SEQ, D_MODEL), 1.0)
    w_in = nrm(ks[1], (L, D_MODEL, D_SSM + 3 * D_ATTN), D_MODEL ** -0.5)
    w_in = w_in.at[:, :, D_SSM + 2 * D_ATTN:].multiply(DEEPNORM_BETA)
    u01 = jax.random.uniform(ks[2], (L, SSM_GROUPS, SSM_STATE), f32)
    ssm_log_dt = math.log(DT_MIN) + u01 * (math.log(DT_MAX) - math.log(DT_MIN))
    ssm_a_re = -0.5 + nrm(ks[3], (L, SSM_GROUPS, SSM_STATE), 0.01)
    ssm_a_im = jnp.pi * jnp.arange(SSM_STATE, dtype=f32) + nrm(ks[4], (L, SSM_GROUPS, SSM_STATE), 0.01)
    ssm_b_re = nrm(ks[5], (L, SSM_GROUPS, SSM_STATE, SSM_CH), (2.0 * SSM_CH) ** -0.5)
    ssm_b_im = nrm(ks[6], (L, SSM_GROUPS, SSM_STATE, SSM_CH), (2.0 * SSM_CH) ** -0.5)
    ssm_c_re = nrm(ks[7], (L, SSM_GROUPS, SSM_CH, SSM_STATE), (2.0 * SSM_STATE) ** -0.5)
    ssm_c_im = nrm(ks[8], (L, SSM_GROUPS, SSM_CH, SSM_STATE), (2.0 * SSM_STATE) ** -0.5)
    ssm_d = nrm(ks[9], (L, SSM_GROUPS, SSM_CH), 1.0)
    w_glu = nrm(ks[10], (L, D_SSM, 2 * D_SSM), D_SSM ** -0.5)
    g_ssm_out = 1.0 + nrm(ks[11], (L, D_SSM), 0.02)
    g_attn_out = 1.0 + nrm(ks[12], (L, D_ATTN), 0.02)
    w_out = nrm(ks[13], (L, D_SSM + D_ATTN, D_MODEL), (D_SSM + D_ATTN) ** -0.5 * DEEPNORM_BETA)
    ln1_g = 1.0 + nrm(ks[14], (L, D_MODEL), 0.02)
    ln1_b = nrm(ks[15], (L, D_MODEL), 0.02)
    w_router = nrm(ks[16], (L, D_MODEL, N_EXPERTS), D_MODEL ** -0.5)
    router_bias = nrm(ks[17], (L, N_EXPERTS), 0.01)
    w_gate = nrm(ks[18], (L, N_EXPERTS, D_MODEL, D_EXPERT), D_MODEL ** -0.5)
    w_up = nrm(ks[19], (L, N_EXPERTS, D_MODEL, D_EXPERT), D_MODEL ** -0.5)
    w_down = nrm(ks[20], (L, N_EXPERTS, D_EXPERT, D_MODEL), D_EXPERT ** -0.5 * DEEPNORM_BETA)
    ws_gate = nrm(ks[21], (L, D_MODEL, D_EXPERT), D_MODEL ** -0.5)
    ws_up = nrm(ks[22], (L, D_MODEL, D_EXPERT), D_MODEL ** -0.5)
    ws_down = nrm(ks[23], (L, D_EXPERT, D_MODEL), D_EXPERT ** -0.5 * DEEPNORM_BETA)
    ln2_g = 1.0 + nrm(ks[24], (L, D_MODEL), 0.02)
    ln2_b = nrm(ks[25], (L, D_MODEL), 0.02)
    return {'x': x, 'w_in': w_in, 'ssm_log_dt': ssm_log_dt, 'ssm_a_re': ssm_a_re, 'ssm_a_im': ssm_a_im,
            'ssm_b_re': ssm_b_re, 'ssm_b_im': ssm_b_im, 'ssm_c_re': ssm_c_re, 'ssm_c_im': ssm_c_im,
            'ssm_d': ssm_d, 'w_glu': w_glu, 'g_ssm_out': g_ssm_out, 'g_attn_out': g_attn_out,
            'w_out': w_out, 'ln1_g': ln1_g, 'ln1_b': ln1_b, 'w_router': w_router,
            'router_bias': router_bias, 'w_gate': w_gate, 'w_up': w_up, 'w_down': w_down,
            'ws_gate': ws_gate, 'ws_up': ws_up, 'ws_down': ws_down, 'ln2_g': ln2_g, 'ln2_b': ln2_b}


def reference(x, w_in, ssm_log_dt, ssm_a_re, ssm_a_im, ssm_b_re, ssm_b_im, ssm_c_re, ssm_c_im,
              ssm_d, w_glu, g_ssm_out, g_attn_out, w_out, ln1_g, ln1_b, w_router, router_bias,
              w_gate, w_up, w_down, ws_gate, ws_up, ws_down, ln2_g, ln2_b):
    slopes = 2.0 ** (-8.0 * jnp.arange(1, N_HEADS + 1, dtype=jnp.float32) / N_HEADS)
    h = x
    for layer in range(DEPTH):
        proj = h @ w_in[layer]
        u, q, k, v = jnp.split(proj, [D_SSM, D_SSM + D_ATTN, D_SSM + 2 * D_ATTN], axis=-1)
        y_ssm = _s5_mixer(u, ssm_log_dt[layer], ssm_a_re[layer], ssm_a_im[layer], ssm_b_re[layer],
                          ssm_b_im[layer], ssm_c_re[layer], ssm_c_im[layer], ssm_d[layer], w_glu[layer])
        y_attn = _attention_mixer(q, k, v, slopes)
        merged = jnp.concatenate([_rms_norm(y_ssm, g_ssm_out[layer]), _rms_norm(y_attn, g_attn_out[layer])], axis=-1)
        h = _layer_norm(DEEPNORM_ALPHA * h + merged @ w_out[layer], ln1_g[layer], ln1_b[layer])
        ffn = _moe(h, w_router[layer], router_bias[layer], w_gate[layer], w_up[layer], w_down[layer],
                   ws_gate[layer], ws_up[layer], ws_down[layer])
        h = _layer_norm(DEEPNORM_ALPHA * h + ffn, ln2_g[layer], ln2_b[layer])
    return h
```

```cpp
#include <hip/hip_runtime.h>
#include <math.h>
#include <stdint.h>
#include <cstdio>

#define NTOK 8192
#define SEQ 2048
#define DM 2048
#define DSSM 1024
#define DATT 1024
#define NPROJ 4096
#define NEXP 64
#define DEXP 512
#define CAP 8192
#define ALPHA 1.189207115002721f
#define EPS 1e-5f

#define GAS __attribute__((address_space(1)))
#define LAS __attribute__((address_space(3)))
typedef unsigned short bf16_t;
typedef short bf16x8 __attribute__((ext_vector_type(8)));
typedef short s16x4 __attribute__((ext_vector_type(4)));
typedef float f32x4 __attribute__((ext_vector_type(4)));
typedef float f32x2 __attribute__((ext_vector_type(2)));
typedef float f32x16 __attribute__((ext_vector_type(16)));
typedef unsigned u32x4 __attribute__((ext_vector_type(4)));
typedef unsigned u32x2 __attribute__((ext_vector_type(2)));
typedef GAS unsigned gu32;
typedef int i32x8 __attribute__((ext_vector_type(8)));

constexpr float C2Q = 0.125f * 1.4426950408889634f;
constexpr float LOG2E = 1.4426950408889634f;

__device__ __forceinline__ unsigned f2bf(float f) { unsigned u = __builtin_bit_cast(unsigned, f); return (u + 0x7fffu + ((u >> 16) & 1u)) >> 16; }
typedef __bf16 hwbf16x2 __attribute__((ext_vector_type(2)));
__device__ __forceinline__ unsigned pk2(float lo, float hi) { f32x2 v = {lo, hi}; hwbf16x2 b = __builtin_convertvector(v, hwbf16x2); return __builtin_bit_cast(unsigned, b); }
__device__ __forceinline__ unsigned pk4_fp8(float a, float b, float c, float d) { int w = 0; w = __builtin_amdgcn_cvt_pk_fp8_f32(a, b, w, false); w = __builtin_amdgcn_cvt_pk_fp8_f32(c, d, w, true); return (unsigned)w; }
__device__ __forceinline__ float bf2f(unsigned short b) { return __builtin_bit_cast(float, (unsigned)b << 16); }
__device__ __forceinline__ float bflo(unsigned w) { return __builtin_bit_cast(float, w << 16); }
__device__ __forceinline__ float bfhi(unsigned w) { return __builtin_bit_cast(float, w & 0xffff0000u); }
__device__ __forceinline__ float gelu_tanh_f(float x) { const float u = 0.7978845608028654f * (x + 0.044715f * x * x * x); const float e = __expf(2.f * u); return x * (1.f - __builtin_amdgcn_rcpf(e + 1.f)); }
__device__ __forceinline__ float sigmoid_f(float x) { return __builtin_amdgcn_rcpf(1.f + __expf(-x)); }
__device__ __forceinline__ int fresh_lane() { int l = (int)__builtin_amdgcn_mbcnt_hi(~0u, __builtin_amdgcn_mbcnt_lo(~0u, 0u)); asm volatile("" : "+v"(l)); return l; }
template <int K> __device__ __forceinline__ float shx(float v) {
    if constexpr (K < 32) return __builtin_bit_cast(float, __builtin_amdgcn_ds_swizzle(__builtin_bit_cast(int, v), (K << 10) | 0x1f));
    else { const unsigned u = __builtin_bit_cast(unsigned, v); auto rr = __builtin_amdgcn_permlane32_swap(u, u, false, false);
        const float a = __builtin_bit_cast(float, (unsigned)rr[0]), b = __builtin_bit_cast(float, (unsigned)rr[1]);
        return (int)__builtin_amdgcn_mbcnt_hi(~0u, __builtin_amdgcn_mbcnt_lo(~0u, 0u)) < 32 ? b : a; }
}
template <int K> __device__ __forceinline__ float shx_sum(float v) {
    if constexpr (K < 32) return v + shx<K>(v);
    else { const unsigned u = __builtin_bit_cast(unsigned, v); auto rr = __builtin_amdgcn_permlane32_swap(u, u, false, false); return __builtin_bit_cast(float, (unsigned)rr[0]) + __builtin_bit_cast(float, (unsigned)rr[1]); }
}
template <int K> __device__ __forceinline__ float shx_max(float v) {
    if constexpr (K < 32) return fmaxf(v, shx<K>(v));
    else { const unsigned u = __builtin_bit_cast(unsigned, v); auto rr = __builtin_amdgcn_permlane32_swap(u, u, false, false); return fmaxf(__builtin_bit_cast(float, (unsigned)rr[0]), __builtin_bit_cast(float, (unsigned)rr[1])); }
}
__device__ __forceinline__ float wave_max_f(float v) { v = shx_max<1>(v); v = shx_max<2>(v); v = shx_max<4>(v); v = shx_max<8>(v); v = shx_max<16>(v); return shx_max<32>(v); }
__device__ __forceinline__ float wave_sum_f(float v) { v = shx_sum<1>(v); v = shx_sum<2>(v); v = shx_sum<4>(v); v = shx_sum<8>(v); v = shx_sum<16>(v); return shx_sum<32>(v); }

namespace g8 {
constexpr int BM = 256, BK = 64, HALF = 128, HTB = HALF * BK * 2  , STAGE_BYTES = 8 * HTB;

__host__ __device__ __forceinline__ int lds_byte(int r, int c) { const int st = (r >> 4) * 2 + (c >> 5), rr = r & 15, cc = c & 31, ob = rr * 64 + cc * 2; return st * 1024 + (ob ^ (((ob >> 9) & 1) << 5)); }
__host__ __device__ __forceinline__ void stage_rc(int b, int& R, int& C) { const int st = b / 1024, sb = b % 1024, swz = sb ^ (((sb >> 9) & 1) << 5); R = (st >> 1) * 16 + swz / 64; C = (st & 1) * 32 + (swz % 64) / 2; }
__host__ __device__ __forceinline__ int perm32(int rho) { const int n = rho >> 4, i = rho & 15; return 8 * (i >> 2) + 4 * n + (i & 3); }

struct Unit { int pm, pn, e, seg, rows, aux; };

template <bool F8, class Epi, class Sched>
__device__ __forceinline__ void gemm_phase_t(LAS unsigned char* lds, const Sched& S, const Epi& E, int wid) {
    constexpr bool GATHER = Sched::GATHER;
    const int lane = fresh_lane(), tid = wid * 64 + lane, wr = wid >> 2, wc = wid & 3, fr = lane & 15, fq = lane >> 4;
    const int nt = S.nt;
    const unsigned lda = S.lda, ldb = S.ldb;
    int R0, C0;
    { const int sb = lane * 16, swz = sb ^ (((sb >> 9) & 1) << (F8 ? 4 : 5)); R0 = (wid >> 1) * 16 + swz / 64; C0 = (wid & 1) * 32 + (swz % 64) / 2; }
    constexpr int PM = (int)Epi::PERM;
    const int rho0 = PM ? ((R0 & ~31) + perm32(R0 & 31)) : R0;
    const int Rb0 = (PM == 2) ? 16 * (rho0 >> 3) + (rho0 & 7) : rho0;
    const unsigned voffB = (unsigned)Rb0 * ldb + (unsigned)C0 * 2u;
    const unsigned voffA = (unsigned)R0 * lda + (unsigned)C0 * 2u;
    const size_t kstep = (size_t)(BK * 2);
    const size_t hstepB = (size_t)((PM == 2) ? 8 : HALF) * ldb, hstepA = (size_t)HALF * lda, qB = (size_t)((PM == 2) ? 128 : 64) * ldb, qA = (size_t)64 * lda;
    const unsigned ldsw = (unsigned)wid * 1024u;
    const int f8o = (fq >> 1) * 1024 + fr * 64 + (fq & 1) * 32, f8s = (fr >> 3) * 16;
    const int aoff = F8 ? wr * 8192 + f8o + f8s : lds_byte(wr * 64 + fr, fq * 8), boff = F8 ? wc * 4096 + f8o + f8s : lds_byte(wc * 32 + fr, fq * 8);
    const int hi8 = 16 - 2 * f8s;
#define G8_SA(b, h) (((b) * 2 + (h)) * HTB)
#define G8_SB(b, h) ((4 + (b) * 2 + (h)) * HTB)
#define G8_GLDS(gptr, ldsoff) __builtin_amdgcn_global_load_lds((const unsigned*)(gptr), (LAS unsigned*)(lds + (ldsoff)), 16, 0, 0)
#define G8_OPQ(x) ({ unsigned o_ = (x); asm volatile("" : "+v"(o_)); o_; })
#define G8_STAGE_B(bufoff, gbase) do { const unsigned o_ = G8_OPQ(voffB); G8_GLDS((const char*)(gbase) + o_, (bufoff) + ldsw); G8_GLDS((const char*)(gbase) + qB + o_, (bufoff) + ldsw + 8192); } while (0)
#define G8_STAGE_A(bufoff, gbase, h, gv) do { if constexpr (GATHER) { const unsigned o0_ = G8_OPQ((gv)[0]), o1_ = G8_OPQ((gv)[1]); G8_GLDS((const char*)(gbase) + o0_, (bufoff) + ldsw); G8_GLDS((const char*)(gbase) + o1_, (bufoff) + ldsw + 8192); } \
        else { const unsigned o_ = G8_OPQ(voffA); G8_GLDS((const char*)(gbase) + (h) * hstepA + o_, (bufoff) + ldsw); G8_GLDS((const char*)(gbase) + (h) * hstepA + qA + o_, (bufoff) + ldsw + 8192); } } while (0)
#define G8_LDA(dst, b, h) do { _Pragma("unroll") for (int m = 0; m < 4; ++m) _Pragma("unroll") for (int k = 0; k < 2; ++k) dst[m][k] = *(const LAS bf16x8*)(lds + G8_SA(b, h) + aoff + m * 2048 + k * 1024); } while (0)
#define G8_LDB(dst, b, h) do { _Pragma("unroll") for (int n = 0; n < 2; ++n) _Pragma("unroll") for (int k = 0; k < 2; ++k) dst[n][k] = *(const LAS bf16x8*)(lds + G8_SB(b, h) + boff + n * 2048 + k * 1024); } while (0)
#define G8_LD8(dst, off) do { const u32x4 lo_ = *(const LAS u32x4*)(lds + (off)), hi_ = *(const LAS u32x4*)(lds + (off) + hi8); \
        dst = (i32x8){(int)lo_[0], (int)lo_[1], (int)lo_[2], (int)lo_[3], (int)hi_[0], (int)hi_[1], (int)hi_[2], (int)hi_[3]}; } while (0)
#define G8_LDA8(dst, b, h) do { _Pragma("unroll") for (int m = 0; m < 4; ++m) G8_LD8(dst[m], G8_SA(b, h) + aoff + m * 2048); } while (0)
#define G8_LDB8(dst, b, h) do { _Pragma("unroll") for (int n = 0; n < 2; ++n) G8_LD8(dst[n], G8_SB(b, h) + boff + n * 2048); } while (0)
#define G8_MMA8(ai, bj, At, Bt) do { __builtin_amdgcn_s_setprio(1); _Pragma("unroll") for (int m = 0; m < 4; ++m) _Pragma("unroll") for (int n = 0; n < 2; ++n) \
        asm volatile("v_mfma_scale_f32_16x16x128_f8f6f4 %0, %1, %2, %0, %3, %3 op_sel_hi:[0,0,0]" : "+v"(acc[ai][bj][m][n]) : "v"(Bt[n]), "v"(At[m]), "v"(one8)); __builtin_amdgcn_s_setprio(0); } while (0)
#define G8_MMA(ai, bj, At, Bt) do { __builtin_amdgcn_s_setprio(1); _Pragma("unroll") for (int m = 0; m < 4; ++m) _Pragma("unroll") for (int n = 0; n < 2; ++n) _Pragma("unroll") for (int k = 0; k < 2; ++k) \
        acc[ai][bj][m][n] = __builtin_amdgcn_mfma_f32_16x16x32_bf16(Bt[n][k], At[m][k], acc[ai][bj][m][n], 0, 0, 0); __builtin_amdgcn_s_setprio(0); } while (0)
#define G8_WAIT_V(n) asm volatile("s_waitcnt vmcnt(" #n ")" ::: "memory")
#define G8_WAIT_L(n) asm volatile("s_waitcnt lgkmcnt(" #n ")" ::: "memory")
#define G8_BAR __builtin_amdgcn_s_barrier()
#define G8_SCHED __builtin_amdgcn_sched_barrier(0)
    Unit cur, nxt; int ui = 0;
    if (!S.next(0, cur)) return;
    f32x4 acc[2][2][4][2];
#pragma unroll
    for (int a = 0; a < 2; ++a)
#pragma unroll
        for (int b = 0; b < 2; ++b)
#pragma unroll
            for (int m = 0; m < 4; ++m)
#pragma unroll
                for (int n = 0; n < 2; ++n) acc[a][b][m][n] = (f32x4){0.f, 0.f, 0.f, 0.f};
    bf16x8 At[4][2], B0[2][2], B1[2][2]; i32x8 At8[4], B08[2], B18[2]; const int one8 = 0x7f7f7f7f;
    const char* cA = S.a_base(cur); const char* cB = S.b_base(cur);
    {   unsigned vG0[2] = {0u, 0u}, vG1[2] = {0u, 0u};
        if constexpr (GATHER) S.g_off(cur, R0, C0 * 2, vG0, vG1);
    G8_STAGE_B(G8_SB(0, 0), cB); G8_STAGE_B(G8_SB(0, 1), cB + hstepB); G8_STAGE_A(G8_SA(0, 0), cA, 0, vG0); G8_STAGE_A(G8_SA(0, 1), cA, 1, vG1);
    if (wr == 1) G8_BAR;
    G8_WAIT_V(2); G8_BAR;
    G8_STAGE_B(G8_SB(1, 0), cB + kstep); G8_STAGE_A(G8_SA(1, 0), cA + kstep, 0, vG0); G8_STAGE_B(G8_SB(1, 1), cB + hstepB + kstep);
    G8_WAIT_V(6); G8_BAR; }
    for (;;) {
        const bool has_next = S.next(ui + 1, nxt);
        const char* nA = has_next ? S.a_base(nxt) : cA; const char* nB = has_next ? S.b_base(nxt) : cB;
        for (int t = 0; t < nt; t += 2) {
            const bool last = (t == nt - 2);
            const char* a1 = cA + (size_t)(t + 1) * kstep;
            const char* a2 = last ? nA : cA + (size_t)(t + 2) * kstep; const char* b2 = last ? nB : cB + (size_t)(t + 2) * kstep;
            const char* a3 = a2 + kstep; const char* b3 = b2 + kstep;
            unsigned vG0[2] = {0u, 0u}, vG1[2] = {0u, 0u}, x0[2] = {0u, 0u}, x1[2] = {0u, 0u};
            if constexpr (GATHER) { S.g_off(cur, R0, C0 * 2, vG0, vG1); if (last && has_next) S.g_off(nxt, R0, C0 * 2, x0, x1); else { x0[0] = vG0[0]; x0[1] = vG0[1]; x1[0] = vG1[0]; x1[1] = vG1[1]; } }
            if constexpr (!F8) {
            G8_LDB(B0, 0, 0); G8_LDB(B1, 0, 1); G8_SCHED; G8_LDA(At, 0, 0); G8_STAGE_A(G8_SA(1, 1), a1, 1, vG1);
            G8_WAIT_V(8); G8_WAIT_L(0); G8_BAR; G8_MMA(0, 0, At, B0); G8_MMA(0, 1, At, B1); G8_BAR; G8_SCHED;
            G8_LDA(At, 0, 1); G8_STAGE_B(G8_SB(0, 0), b2); G8_STAGE_B(G8_SB(0, 1), b2 + hstepB); G8_STAGE_A(G8_SA(0, 0), a2, 0, x0);
            G8_WAIT_V(8); G8_WAIT_L(0); G8_BAR; G8_MMA(1, 0, At, B0); G8_MMA(1, 1, At, B1); G8_BAR; G8_SCHED;
            G8_LDB(B0, 1, 0); G8_LDB(B1, 1, 1); G8_SCHED; G8_LDA(At, 1, 0); G8_STAGE_A(G8_SA(0, 1), a2, 1, x1);
            G8_WAIT_V(8); G8_WAIT_L(0); G8_BAR; G8_MMA(0, 0, At, B0); G8_MMA(0, 1, At, B1); G8_BAR; G8_SCHED;
            G8_LDA(At, 1, 1); G8_STAGE_B(G8_SB(1, 0), b3); G8_STAGE_B(G8_SB(1, 1), b3 + hstepB); G8_STAGE_A(G8_SA(1, 0), a3, 0, x0);
            G8_WAIT_V(8); G8_WAIT_L(0); G8_BAR; G8_MMA(1, 0, At, B0); G8_MMA(1, 1, At, B1); G8_BAR; G8_SCHED;
            } else {
            G8_LDB8(B08, 0, 0); G8_LDB8(B18, 0, 1); G8_SCHED; G8_LDA8(At8, 0, 0); G8_STAGE_A(G8_SA(1, 1), a1, 1, vG1);
            G8_WAIT_V(8); G8_WAIT_L(0); G8_BAR; G8_MMA8(0, 0, At8, B08); G8_MMA8(0, 1, At8, B18); G8_BAR; G8_SCHED;
            G8_LDA8(At8, 0, 1); G8_STAGE_B(G8_SB(0, 0), b2); G8_STAGE_B(G8_SB(0, 1), b2 + hstepB); G8_STAGE_A(G8_SA(0, 0), a2, 0, x0);
            G8_WAIT_V(8); G8_WAIT_L(0); G8_BAR; G8_MMA8(1, 0, At8, B08); G8_MMA8(1, 1, At8, B18); G8_BAR; G8_SCHED;
            G8_LDB8(B08, 1, 0); G8_LDB8(B18, 1, 1); G8_SCHED; G8_LDA8(At8, 1, 0); G8_STAGE_A(G8_SA(0, 1), a2, 1, x1);
            G8_WAIT_V(8); G8_WAIT_L(0); G8_BAR; G8_MMA8(0, 0, At8, B08); G8_MMA8(0, 1, At8, B18); G8_BAR; G8_SCHED;
            G8_LDA8(At8, 1, 1); G8_STAGE_B(G8_SB(1, 0), b3); G8_STAGE_B(G8_SB(1, 1), b3 + hstepB); G8_STAGE_A(G8_SA(1, 0), a3, 0, x0);
            G8_WAIT_V(8); G8_WAIT_L(0); G8_BAR; G8_MMA8(1, 0, At8, B08); G8_MMA8(1, 1, At8, B18); G8_BAR; G8_SCHED;
            }
        }
        if constexpr (F8) asm volatile("s_nop 15\n\ts_nop 15" ::: "memory");
        if (wr == 0) G8_BAR;
        { const int l2 = fresh_lane(); E(acc, cur, wr, wc, l2 & 15, l2 >> 4); }
        if (!has_next) break;
        if (!E.keep(cur)) {
#pragma unroll
            for (int a = 0; a < 2; ++a)
#pragma unroll
                for (int b = 0; b < 2; ++b)
#pragma unroll
                    for (int m = 0; m < 4; ++m)
#pragma unroll
                        for (int n = 0; n < 2; ++n) acc[a][b][m][n] = (f32x4){0.f, 0.f, 0.f, 0.f};
        }
        cur = nxt; cA = nA; cB = nB; ++ui;
        if (wr == 1) G8_BAR;
    }
    G8_WAIT_V(0);
    G8_BAR;
#undef G8_SA
#undef G8_SB
#undef G8_GLDS
#undef G8_OPQ
#undef G8_STAGE_A
#undef G8_STAGE_B
#undef G8_LDA
#undef G8_LDB
#undef G8_LDA8
#undef G8_LD8
#undef G8_LDB8
#undef G8_MMA8
#undef G8_MMA
#undef G8_WAIT_V
#undef G8_WAIT_L
#undef G8_BAR
#undef G8_SCHED
}
template <class Epi, class Sched> __device__ __forceinline__ void gemm_phase(LAS unsigned char* lds, const Sched& S, const Epi& E, int wid) { gemm_phase_t<false>(lds, S, E, wid); }
template <class Epi, class Sched> __device__ __forceinline__ void gemm_phase_f8(LAS unsigned char* lds, const Sched& S, const Epi& E, int wid) { gemm_phase_t<true>(lds, S, E, wid); }

struct DenseSched {
    static constexpr bool GATHER = false;
    const char* A; const char* Bt; unsigned lda, ldb; int nM, nN, nseg, nt, G, c; unsigned segbytes; int lo, hi;
    __device__ __forceinline__ bool next(int i_, Unit& u) const {
        const int i = i_ + lo; if (i >= hi) return false;
        const int tile = (i / nseg) * G + c; if (tile >= nM * nN) return false;
        const int nig = 8 * nN, gid = tile / nig, fm = gid * 8, gsz = (nM - fm) < 8 ? (nM - fm) : 8;
        u.pm = fm + ((tile % nig) % gsz); u.pn = (tile % nig) / gsz; u.e = 0; u.seg = i % nseg; u.rows = 256; u.aux = 0; return true;
    }
    __device__ __forceinline__ const char* a_base(const Unit& u) const { return A + (size_t)u.pm * 256 * lda + (size_t)u.seg * segbytes; }
    __device__ __forceinline__ const char* b_base(const Unit& u) const { return Bt + (size_t)u.pn * 256 * ldb + (size_t)u.seg * segbytes; }
};
}

constexpr int NWAVES = 8;
constexpr size_t MiB = 1u << 20;
constexpr size_t WS_CTL = 0, CTL_ZERO_BYTES = 64 * 1024;
constexpr size_t WS_WR = 1 * MiB;
constexpr size_t WS_LIST = 1536 * 1024;
constexpr size_t WS_H1 = 8 * MiB;
constexpr size_t WS_WGU = 40 * MiB;
constexpr size_t WS_WD = 300 * MiB;
constexpr size_t WS_ACT = 430 * MiB;
constexpr size_t WS_PRE1 = 430 * MiB;
constexpr size_t WS_Y = 518 * MiB;
constexpr size_t WS_WIN = 518 * MiB;
constexpr size_t WS_WGLU = 534 * MiB;
constexpr size_t WS_WOUT = 538 * MiB;
constexpr size_t WS_XB = 546 * MiB;
constexpr size_t WS_UG = 578 * MiB;
constexpr size_t WS_QH = 594 * MiB;
constexpr size_t WS_KH = 610 * MiB;
constexpr size_t WS_VH = 626 * MiB;
constexpr size_t WS_SW1 = 642 * MiB;
constexpr size_t WS_SWC = 650 * MiB;
constexpr size_t WS_GY = 690 * MiB;
constexpr size_t WS_MG = 706 * MiB;
constexpr size_t WS_OP = 738 * MiB;
constexpr size_t WS_H1F = 370 * MiB;
constexpr size_t WS_TAB = 790 * MiB;
constexpr size_t WS_PART = 792 * MiB;
constexpr size_t WS_END = 806 * MiB;
constexpr int CW_BAR = 4096;
constexpr int CW_QD = 11936;
constexpr int CW_QM = 12000, CW_QC = 12064;
constexpr int CW_CNT = 12288;
static_assert((CW_CNT + 128) * 4 <= (int)CTL_ZERO_BYTES, "ctl");

constexpr size_t PART_SS = 0, PART_SA = 32 * 8192, PART_LS = 48 * 8192, PART_LQ = 80 * 8192;
constexpr float YSCALE8 = 32.f, YUNSCALE8 = 1.f / 32.f;
constexpr float WSCALE8 = 32.f, WUNSCALE8 = 1.f / 32.f;
constexpr int RING_BYTES = 131072, MISC_OFF = RING_BYTES, LDS_BYTES = 147456;

#define RLX_AGENT __ATOMIC_RELAXED, __HIP_MEMORY_SCOPE_AGENT
#define LDS_WAIT() asm volatile("s_waitcnt lgkmcnt(0)" ::: "memory")
#define VM_WAIT() asm volatile("s_waitcnt vmcnt(0)" ::: "memory")

#define XB_TMO      128
#define XB_XCNT(j)  (256  + 64 * (j))
#define XB_XSUB(j)  (1280 + 64 * (j))
#define XB_XGEN(j)  (2304 + 64 * (j))
#define XB_TOP      3328
#define XB_TOPGEN   3392
#define XCD_BAR_WORDS 3456
#define XB_SPIN_CAP (1u << 22)
__device__ __forceinline__ unsigned xb_ld(unsigned* p)              { return __hip_atomic_load(p, __ATOMIC_RELAXED, __HIP_MEMORY_SCOPE_AGENT); }
__device__ __forceinline__ unsigned xb_add(unsigned* p, unsigned v) { return __hip_atomic_fetch_add(p, v, __ATOMIC_RELAXED, __HIP_MEMORY_SCOPE_AGENT); }
__device__ __forceinline__ unsigned xb_xcc_id() { return (unsigned)__builtin_amdgcn_s_getreg((3 << 11) | 20) & 0xFu; }
#define XB_SPIN(cond, bar) do { unsigned _sp = 0; while (cond) { __builtin_amdgcn_s_sleep(1); \
    if ((++_sp & 255u) == 0u) { if (xb_ld(&(bar)[XB_TMO])) break; if (_sp > XB_SPIN_CAP) { atomicAdd(&(bar)[XB_TMO], 1u); break; } } } } while (0)
struct XcdBarrier { unsigned* bar; unsigned x; volatile LAS unsigned* st; };
__device__ __forceinline__ XcdBarrier xcd_barrier_post(unsigned* bar, volatile LAS unsigned* st) {
    XcdBarrier b; b.bar = bar; b.x = xb_xcc_id(); b.st = st;
    if (threadIdx.x == 0) (void)xb_add(&bar[XB_XCNT(b.x)], 1u);
    return b;
}
__device__ __forceinline__ void xcd_barrier_complete(unsigned* bar, unsigned x, unsigned& nloc, unsigned& nx) {
    const unsigned G = gridDim.x * gridDim.y * gridDim.z;
    unsigned sum, cnt, mine, sp = 0u;
    for (;;) {
        sum = 0u; cnt = 0u; mine = 0u;
#pragma unroll
        for (unsigned j = 0; j < 16; ++j) { const unsigned c = xb_ld(&bar[XB_XCNT(j)]); sum += c; cnt += (c > 0u) ? 1u : 0u; mine = (j == x) ? c : mine; }
        if (sum == G) break;
        __builtin_amdgcn_s_sleep(1);
        if ((++sp & 255u) == 0u) { if (xb_ld(&bar[XB_TMO])) break; if (sp > XB_SPIN_CAP) { atomicAdd(&bar[XB_TMO], 1u); break; } }
    }
    nloc = mine > 0u ? mine : 1u; nx = cnt > 0u ? cnt : 1u;
}
__device__ __forceinline__ void xcd_barrier(const XcdBarrier& b, int wave) {
    asm volatile("s_waitcnt vmcnt(0)" ::: "memory");
    __syncthreads();
    if (wave == 0 && fresh_lane() == 0) {
        unsigned* bar = b.bar;
        __builtin_amdgcn_s_waitcnt(0);
        unsigned nloc = b.st[0], nx = b.st[1];
        if (nloc == 0u) { xcd_barrier_complete(bar, b.x, nloc, nx); b.st[0] = nloc; b.st[1] = nx; }
        const unsigned old = xb_add(&bar[XB_XSUB(b.x)], 1u);
        const unsigned gen = old / nloc;
        if (old + 1u == (gen + 1u) * nloc) {
            __builtin_amdgcn_fence(__ATOMIC_RELEASE, "agent");
            asm volatile("s_waitcnt vmcnt(0)" ::: "memory");
            const unsigned og = xb_add(&bar[XB_TOP], 1u);
            const unsigned tg = og / nx;
            if (og + 1u == (tg + 1u) * nx) xb_add(&bar[XB_TOPGEN], 1u);
            else XB_SPIN(xb_ld(&bar[XB_TOPGEN]) == tg, bar);
            __builtin_amdgcn_fence(__ATOMIC_ACQUIRE, "agent");
            xb_add(&bar[XB_XGEN(b.x)], 1u);
            asm volatile("s_waitcnt vmcnt(0)" ::: "memory");
        } else {
            XB_SPIN(xb_ld(&bar[XB_XGEN(b.x)]) == gen, bar);
            __builtin_amdgcn_fence(__ATOMIC_ACQUIRE, "agent");
            asm volatile("s_waitcnt vmcnt(0)" ::: "memory");
        }
    }
    __syncthreads();
}

struct Args { const float* in[26]; float* out; unsigned char* ws; int ph_lo, ph_hi, use_bar, pad; };
struct Frame {
    LAS unsigned char* lds; volatile LAS unsigned* MISC; unsigned* ctl; unsigned char* ws;
    int tid, lane, wave, vcu, G;
};

__device__ __forceinline__ void transpose_item(const float* W, int N, bf16_t* WT, int ldt, int k0, int n0, int orow0, const float* kscale, LAS unsigned char* tile, int lane) {
    const int lr = lane >> 4, lc = lane & 15;
    f32x4 v[16];
#pragma unroll
    for (int i = 0; i < 16; ++i) v[i] = __builtin_nontemporal_load((const GAS f32x4*)(W + (size_t)(k0 + 4 * i + lr) * N + n0 + 4 * lc));
#pragma unroll
    for (int i = 0; i < 16; ++i) { f32x4 x = v[i]; if (kscale) x = x * kscale[k0 + 4 * i + lr];
        u32x2 o; o.x = pk2(x[0], x[1]); o.y = pk2(x[2], x[3]); *(LAS u32x2*)(tile + (4 * i + lr) * 144 + lc * 8) = o; }
    asm volatile("s_waitcnt lgkmcnt(0)" ::: "memory");
    const int G = lane >> 4, q = (lane & 15) >> 2, pp = lane & 3;
#pragma unroll
    for (int t = 0; t < 8; ++t) { const int nb = t & 3, c = 4 * (t >> 2) + G;
        LAS unsigned char* a = tile + (8 * c + q) * 144 + (16 * nb + 4 * pp) * 2;
        const s16x4 t0 = __builtin_bit_cast(s16x4, __builtin_amdgcn_ds_read_tr16_b64_v4i16((LAS s16x4*)a));
        const s16x4 t1 = __builtin_bit_cast(s16x4, __builtin_amdgcn_ds_read_tr16_b64_v4i16((LAS s16x4*)(a + 4 * 144)));
        const bf16x8 o = (bf16x8){t0[0], t0[1], t0[2], t0[3], t1[0], t1[1], t1[2], t1[3]};
        *(GAS bf16x8*)(WT + (size_t)(orow0 + 16 * nb + (lane & 15)) * ldt + k0 + 8 * c) = o; }
    asm volatile("s_waitcnt lgkmcnt(0)" ::: "memory");
}
__device__ __forceinline__ int glu_row(int j) { return (j >> 7) * 256 + (j & 127); }
struct F8Item { const float* W; unsigned char* WT8; int N, ldt, k0, n0, orow0; };
__device__ __forceinline__ void f8_item_load(const F8Item& it, f32x4 (&v)[16], int lane) {
    const int lr = lane >> 4, lc = lane & 15;
#pragma unroll
    for (int i = 0; i < 16; ++i) v[i] = __builtin_nontemporal_load((const GAS f32x4*)(it.W + (size_t)(it.k0 + 4 * i + lr) * it.N + it.n0 + 4 * lc));
}
__device__ __forceinline__ void f8_item_process(const F8Item& it, const f32x4 (&v)[16], float wscale, LAS unsigned char* tile, int lane) {
    const int lr = lane >> 4, lc = lane & 15;
#pragma unroll
    for (int i = 0; i < 16; ++i) { const f32x4 x = v[i] * wscale; u32x2 o; o.x = pk2(x[0], x[1]); o.y = pk2(x[2], x[3]); *(LAS u32x2*)(tile + (4 * i + lr) * 144 + lc * 8) = o; }
    asm volatile("s_waitcnt lgkmcnt(0)" ::: "memory");
    const int G = lane >> 4, q = (lane & 15) >> 2, pp = lane & 3;
#pragma unroll
    for (int t = 0; t < 4; ++t) {
        LAS unsigned char* a = tile + (16 * G + q) * 144 + (16 * t + 4 * pp) * 2; u32x4 o;
#pragma unroll
        for (int j = 0; j < 4; ++j) { const s16x4 tr = __builtin_bit_cast(s16x4, __builtin_amdgcn_ds_read_tr16_b64_v4i16((LAS s16x4*)(a + 4 * j * 144)));
            o[j] = pk4_fp8(bf2f((unsigned short)tr[0]), bf2f((unsigned short)tr[1]), bf2f((unsigned short)tr[2]), bf2f((unsigned short)tr[3])); }
        *(GAS u32x4*)(it.WT8 + (size_t)(it.orow0 + 16 * t + (lane & 15)) * it.ldt + it.k0 + 16 * G) = o; }
    asm volatile("s_waitcnt lgkmcnt(0)" ::: "memory");
}
__device__ __forceinline__ F8Item f8_item_of(const Args& args, unsigned char* ws, int set, int it) {
    constexpr int I_G = 32 * 8; F8Item d;
    if (set == 0) { const int e = it / (2 * I_G); int r = it - e * 2 * I_G; const int up = r >= I_G ? 1 : 0; r -= up * I_G; const int kb = r / 8, nb = r % 8;
        d.W = e < NEXP ? args.in[18 + up] + (size_t)e * DM * DEXP : args.in[21 + up]; d.WT8 = ws + WS_WGU + (size_t)e * 1024 * DM; d.N = DEXP; d.ldt = DM; d.k0 = kb * 64; d.n0 = nb * 64; d.orow0 = glu_row(nb * 64) + 128 * up; }
    else { const int e = it / I_G; const int r = it - e * I_G; const int kb = r / 32, nb = r % 32;
        d.W = e < NEXP ? args.in[20] + (size_t)e * DEXP * DM : args.in[23]; d.WT8 = ws + WS_WD + (size_t)e * DM * DEXP; d.N = DM; d.ldt = DEXP; d.k0 = kb * 64; d.n0 = nb * 64; d.orow0 = nb * 64; }
    return d;
}
__device__ __forceinline__ void f8_convert_items(const Args& args, unsigned char* ws, LAS unsigned char* lds, int set, int it0, int wave, int lane) {
    LAS unsigned char* tile = lds + wave * 9216;
    f32x4 va[16], vb[16], vc[16];
    F8Item da = f8_item_of(args, ws, set, it0), db = f8_item_of(args, ws, set, it0 + 1), dc = f8_item_of(args, ws, set, it0 + 2);
    f8_item_load(da, va, lane); f8_item_load(db, vb, lane); f8_item_load(dc, vc, lane);
    f8_item_process(da, va, WSCALE8, tile, lane); da = f8_item_of(args, ws, set, it0 + 3); f8_item_load(da, va, lane);
    f8_item_process(db, vb, WSCALE8, tile, lane); db = f8_item_of(args, ws, set, it0 + 4); f8_item_load(db, vb, lane);
    f8_item_process(dc, vc, WSCALE8, tile, lane); dc = f8_item_of(args, ws, set, it0 + 5); f8_item_load(dc, vc, lane);
    f8_item_process(da, va, WSCALE8, tile, lane); da = f8_item_of(args, ws, set, it0 + 6); f8_item_load(da, va, lane);
    f8_item_process(db, vb, WSCALE8, tile, lane); db = f8_item_of(args, ws, set, it0 + 7); f8_item_load(db, vb, lane);
    f8_item_process(dc, vc, WSCALE8, tile, lane);
    f8_item_process(da, va, WSCALE8, tile, lane);
    f8_item_process(db, vb, WSCALE8, tile, lane);
}
__device__ __forceinline__ void f8_convert_chunk(const Args& args, unsigned char* ws, LAS unsigned char* lds, int set, int chunk, int wave, int lane) { f8_convert_items(args, ws, lds, set, chunk * 64 + wave * 8, wave, lane); }
__device__ __forceinline__ void f8_convert_one(const Args& args, unsigned char* ws, LAS unsigned char* lds, int set, int it, int wave, int lane) {
    LAS unsigned char* tile = lds + wave * 9216; f32x4 v[16]; const F8Item d = f8_item_of(args, ws, set, it); f8_item_load(d, v, lane); f8_item_process(d, v, WSCALE8, tile, lane); }
constexpr int NCONV_GU = (65 * 512) / 64, NCONV_D = (65 * 256) / 64;
constexpr int NSUB_D = NCONV_D * 8;

struct EpiIn {
    static constexpr bool PERM = true;
    bf16_t* ug;
    __device__ __forceinline__ bool keep(const g8::Unit&) const { return false; }
    __device__ __forceinline__ void operator()(f32x4 (&acc)[2][2][4][2], const g8::Unit& u, int wr, int wc, int fr, int fq) const {
        asm volatile("" : "+v"(fr), "+v"(fq));
        const int region = u.pn >> 2; const float sc = (region == 1) ? C2Q : 1.f;
        bf16_t* base = ug + (size_t)region * (16 * MiB / 2);
#pragma unroll
        for (int ai = 0; ai < 2; ++ai)
#pragma unroll
            for (int m = 0; m < 4; ++m) {
                const int r = u.pm * 256 + ai * 128 + wr * 64 + m * 16 + fr; const int b = r >> 11, t = r & 2047;
#pragma unroll
                for (int bj = 0; bj < 2; ++bj) {
                    const int c = (u.pn & 3) * 256 + bj * 128 + wc * 32 + 8 * fq;
                    const f32x4 v0 = acc[ai][bj][m][0] * sc, v1 = acc[ai][bj][m][1] * sc;
                    u32x4 w; w.x = pk2(v0[0], v0[1]); w.y = pk2(v0[2], v0[3]); w.z = pk2(v1[0], v1[1]); w.w = pk2(v1[2], v1[3]);
                    size_t off;
                    if (region == 0) off = ((size_t)(b * 64 + (c >> 4)) * 2048 + t) * 16 + (c & 15);
                    else off = ((size_t)(b * 16 + (c >> 6)) * 2048 + t) * 64 + (c & 63);
                    *(GAS u32x4*)(base + off) = w;
                }
            }
    }
};

struct EpiGlu {
    static constexpr bool PERM = true;
    bf16_t* mg; float* ssq;
    __device__ __forceinline__ bool keep(const g8::Unit&) const { return false; }
    __device__ __forceinline__ void operator()(f32x4 (&acc)[2][2][4][2], const g8::Unit& u, int wr, int wc, int fr, int fq) const {
        asm volatile("" : "+v"(fr), "+v"(fq));
        const int col = u.pn * 128 + wc * 32 + 8 * fq;
#pragma unroll
        for (int ai = 0; ai < 2; ++ai)
#pragma unroll
            for (int m = 0; m < 4; ++m) {
                const int r = u.pm * 256 + ai * 128 + wr * 64 + m * 16 + fr;
                float y[8]; float s = 0.f;
#pragma unroll
                for (int n = 0; n < 2; ++n)
#pragma unroll
                    for (int e = 0; e < 4; ++e) { const float v = acc[ai][0][m][n][e] * sigmoid_f(acc[ai][1][m][n][e]); y[4 * n + e] = v; s += v * v; }
                u32x4 w; w.x = pk2(y[0], y[1]); w.y = pk2(y[2], y[3]); w.z = pk2(y[4], y[5]); w.w = pk2(y[6], y[7]);
                *(GAS u32x4*)(mg + (size_t)r * DM + col) = w;
                s = shx_sum<16>(s); s = shx_sum<32>(s);
                if (fq == 0) ssq[(size_t)(u.pn * 4 + wc) * NTOK + r] = s;
            }
    }
};
struct EpiOut {
    static constexpr bool PERM = true;
    const float* x; bf16_t* pre1; const float* part; float* part_w; LAS f32x2* rtab; LAS int* rtab_pm;
    __device__ __forceinline__ bool keep(const g8::Unit& u) const { return u.seg == 0; }
    __device__ __forceinline__ void operator()(f32x4 (&acc)[2][2][4][2], const g8::Unit& u, int wr, int wc, int fr, int fq) const {
        asm volatile("" : "+v"(fr), "+v"(fq));
        if (__builtin_amdgcn_readfirstlane(*rtab_pm) != u.pm) {
            __syncthreads();
            const int t = (wr * 4 + wc) * 64 + fq * 16 + fr;
            if (t < 256) { const int r = u.pm * 256 + t; float ss = 0.f, sa = 0.f;
#pragma unroll 8
                for (int i = 0; i < 32; ++i) ss += part[PART_SS + (size_t)i * NTOK + r];
#pragma unroll 8
                for (int i = 0; i < 16; ++i) sa += part[PART_SA + (size_t)i * NTOK + r];
                rtab[t] = (f32x2){rsqrtf(ss * (1.f / 1024.f) + EPS), rsqrtf(sa * (1.f / 1024.f) + EPS)}; }
            if (t == 0) *rtab_pm = u.pm;
            __syncthreads();
        }
        if (u.seg == 0) {
#pragma unroll
            for (int ai = 0; ai < 2; ++ai)
#pragma unroll
                for (int m = 0; m < 4; ++m) { const f32x2 rr = rtab[ai * 128 + wr * 64 + m * 16 + fr]; const float f = rr.x / rr.y;
#pragma unroll
                    for (int bj = 0; bj < 2; ++bj)
#pragma unroll
                        for (int n = 0; n < 2; ++n) acc[ai][bj][m][n] *= f; }
        } else {
#pragma unroll
            for (int ai = 0; ai < 2; ++ai) { f32x4 xv[4][2][2];
#pragma unroll
                for (int m = 0; m < 4; ++m)
#pragma unroll
                    for (int bj = 0; bj < 2; ++bj) { const size_t off = (size_t)(u.pm * 256 + ai * 128 + wr * 64 + m * 16 + fr) * DM + u.pn * 256 + bj * 128 + wc * 32 + 8 * fq;
                        xv[m][bj][0] = *(const GAS f32x4*)(x + off); xv[m][bj][1] = *(const GAS f32x4*)(x + off + 4); }
                asm volatile("" ::: "memory");
#pragma unroll
                for (int m = 0; m < 4; ++m) { const int rl = ai * 128 + wr * 64 + m * 16 + fr, r = u.pm * 256 + rl; const float ra = rtab[rl].y; float su = 0.f, sq = 0.f;
#pragma unroll
                    for (int bj = 0; bj < 2; ++bj) { const size_t off = (size_t)r * DM + u.pn * 256 + bj * 128 + wc * 32 + 8 * fq;
                        const f32x4 o0 = xv[m][bj][0] * ALPHA + acc[ai][bj][m][0] * ra, o1 = xv[m][bj][1] * ALPHA + acc[ai][bj][m][1] * ra;
                        u32x4 w; w.x = pk2(o0[0], o0[1]); w.y = pk2(o0[2], o0[3]); w.z = pk2(o1[0], o1[1]); w.w = pk2(o1[2], o1[3]);
                        *(GAS u32x4*)(pre1 + off) = w;
                        su += (o0[0] + o0[1]) + (o0[2] + o0[3]) + (o1[0] + o1[1]) + (o1[2] + o1[3]);
                        sq += (o0[0] * o0[0] + o0[1] * o0[1]) + (o0[2] * o0[2] + o0[3] * o0[3]) + (o1[0] * o1[0] + o1[1] * o1[1]) + (o1[2] * o1[2] + o1[3] * o1[3]); }
                    su = shx_sum<16>(su); su = shx_sum<32>(su); sq = shx_sum<16>(sq); sq = shx_sum<32>(sq);
                    if (fq == 0) { part_w[PART_LS + (size_t)(u.pn * 4 + wc) * NTOK + r] = su; part_w[PART_LQ + (size_t)(u.pn * 4 + wc) * NTOK + r] = sq; } }
                asm volatile("" ::: "memory");
            }
        }
    }
};

__device__ __forceinline__ void ssm_prep_item(const Args& args, unsigned char* ws, LAS unsigned char* lds, int g, int qtr, int tid) {
    LAS f32x2* PW = (LAS f32x2*)lds;
    LAS f32x2* BB = (LAS f32x2*)(lds + 16896);
    LAS f32x2* CC = (LAS f32x2*)(lds + 25088);
    LAS float* KM = (LAS float*)(lds + 33280);
    LAS float* DD = (LAS float*)(lds + 66048);
    if (tid < 64) {
        const int p = tid; const float are = fminf(args.in[3][g * 64 + p], -1e-4f), aim = args.in[4][g * 64 + p], dt = expf(args.in[2][g * 64 + p]);
        const float mag = expf(are * dt), abr = mag * cosf(aim * dt), abi = mag * sinf(aim * dt);
        float pr = 1.f, pi = 0.f;
        for (int j = 0; j <= 32; ++j) { PW[j * 64 + p] = (f32x2){pr, pi}; const float nr = pr * abr - pi * abi, ni = pr * abi + pi * abr; pr = nr; pi = ni; }
        const float nr = abr - 1.f, ni = abi, den = are * are + aim * aim; const float cr = (nr * are + ni * aim) / den, ci = (ni * are - nr * aim) / den;
        for (int c = 0; c < 16; ++c) { const float br = args.in[5][(g * 64 + p) * 16 + c], bi = args.in[6][(g * 64 + p) * 16 + c]; BB[p * 16 + c] = (f32x2){cr * br - ci * bi, cr * bi + ci * br}; }
    }
    for (int i = tid; i < 1024; i += 512) { const int c = i >> 6, p = i & 63; CC[p * 16 + c] = (f32x2){args.in[7][(g * 16 + c) * 64 + p], args.in[8][(g * 16 + c) * 64 + p]}; }
    if (tid < 16) DD[tid] = args.in[9][g * 16 + tid];
    __syncthreads();
    if (qtr == 0) {
        const int lane = tid & 63, wv = tid >> 6, cc_ = lane & 15, kq = lane >> 4; f32x4 kacc[4];
#pragma unroll
        for (int jj = 0; jj < 4; ++jj) kacc[jj] = (f32x4){0.f, 0.f, 0.f, 0.f};
#pragma unroll 4
        for (int t = 0; t < 16; ++t) { const int p = 4 * t + kq; const float a = CC[p * 16 + cc_].x; const f32x2 bb = BB[p * 16 + cc_];
#pragma unroll
            for (int jj = 0; jj < 4; ++jj) { const f32x2 pw = PW[(4 * wv + jj) * 64 + p]; kacc[jj] = __builtin_amdgcn_mfma_f32_16x16x4f32(a, pw.x * bb.x - pw.y * bb.y, kacc[jj], 0, 0, 0); } }
#pragma unroll 4
        for (int t = 0; t < 16; ++t) { const int p = 4 * t + kq; const float a = -CC[p * 16 + cc_].y; const f32x2 bb = BB[p * 16 + cc_];
#pragma unroll
            for (int jj = 0; jj < 4; ++jj) { const f32x2 pw = PW[(4 * wv + jj) * 64 + p]; kacc[jj] = __builtin_amdgcn_mfma_f32_16x16x4f32(a, pw.x * bb.y + pw.y * bb.x, kacc[jj], 0, 0, 0); } }
#pragma unroll
        for (int jj = 0; jj < 4; ++jj)
#pragma unroll
            for (int r = 0; r < 4; ++r) KM[(4 * wv + jj) * 256 + (4 * kq + r) * 16 + cc_] = kacc[jj][r];
    }
    __syncthreads();
    bf16_t* W1t = (bf16_t*)(ws + WS_SW1) + (size_t)g * 128 * 512;
    for (int i = tid; i < 32 * 64; i += 512) { const int n = 32 * qtr + (i >> 6), k0 = (i & 63) * 8, p = n & 63, im = n >> 6, s1 = k0 >> 4, c0 = k0 & 15;
        const f32x2 pw = PW[(31 - s1) * 64 + p]; float v[8];
#pragma unroll
        for (int e = 0; e < 8; ++e) { const f32x2 bb = BB[p * 16 + c0 + e]; v[e] = im ? pw.x * bb.y + pw.y * bb.x : pw.x * bb.x - pw.y * bb.y; }
        u32x4 o; o.x = pk2(v[0], v[1]); o.y = pk2(v[2], v[3]); o.z = pk2(v[4], v[5]); o.w = pk2(v[6], v[7]);
        *(GAS u32x4*)(W1t + (size_t)n * 512 + k0) = o; }
    bf16_t* W3t = (bf16_t*)(ws + WS_SWC) + (size_t)g * 512 * 128;
    for (int i = tid; i < 128 * 16; i += 512) { const int n2 = 128 * qtr + (i >> 4), k0 = (i & 15) * 8, s = n2 >> 4, c = n2 & 15, im = k0 >> 6, p0 = k0 & 63; float v[8];
#pragma unroll
        for (int e = 0; e < 8; ++e) { const f32x2 cc = CC[(p0 + e) * 16 + c], pw = PW[(s + 1) * 64 + p0 + e]; v[e] = im ? -(cc.x * pw.y + cc.y * pw.x) : cc.x * pw.x - cc.y * pw.y; }
        u32x4 o; o.x = pk2(v[0], v[1]); o.y = pk2(v[2], v[3]); o.z = pk2(v[4], v[5]); o.w = pk2(v[6], v[7]);
        *(GAS u32x4*)(W3t + (size_t)n2 * 128 + k0) = o; }
    if (qtr == 0) { bf16_t* KT = (bf16_t*)(ws + WS_TAB + 65536) + (size_t)g * 33 * 256;
        for (int i = tid; i < 33 * 32; i += 512) { const int L1 = i >> 5, c = (i & 31) >> 1, c0 = (i & 1) * 8; float v[8];
#pragma unroll
            for (int e = 0; e < 8; ++e) v[e] = L1 == 0 ? 0.f : KM[(L1 - 1) * 256 + c * 16 + c0 + e] + ((L1 == 1 && c0 + e == c) ? DD[c] : 0.f);
            u32x4 o; o.x = pk2(v[0], v[1]); o.y = pk2(v[2], v[3]); o.z = pk2(v[4], v[5]); o.w = pk2(v[6], v[7]);
            *(GAS u32x4*)(KT + (size_t)i * 8) = o; } }
    if (qtr == 0 && tid < 64) ((f32x2*)(ws + WS_TAB))[g * 64 + tid] = PW[32 * 64 + tid];
    __syncthreads();
}

__device__ __forceinline__ void ssm_unit(unsigned char* ws, LAS unsigned char* lds, int b, int g, int tid, int wave, int lane) {
    asm volatile("" : "+v"(lane), "+v"(tid));
    const int fr = lane & 15, fq = lane >> 4;
    LAS unsigned char* UL = lds;
    LAS float* SM = (LAS float*)(lds + 66560);
    LAS unsigned char* HM = lds + 99328;
    const bf16_t* ug = (const bf16_t*)(ws + WS_UG) + (size_t)(b * 64 + g) * 2048 * 16;
#pragma unroll
    for (int j = 0; j < 8; ++j) { const int i = tid + 512 * j, token = i >> 1, half = i & 1; const u32x4 v = *(const GAS u32x4*)(ug + (size_t)i * 8);
        *(LAS u32x4*)(UL + (token >> 5) * 1040 + (token & 31) * 32 + half * 16) = v; }
    __syncthreads();
    {
        const bf16_t* w1 = (const bf16_t*)(ws + WS_SW1) + ((size_t)g * 128 + 16 * wave + fr) * 512 + 8 * fq;
        f32x4 acc[4];
#pragma unroll
        for (int m = 0; m < 4; ++m) acc[m] = (f32x4){0.f, 0.f, 0.f, 0.f};
#pragma unroll 4
        for (int ks = 0; ks < 16; ++ks) { const bf16x8 a = *(const GAS bf16x8*)(w1 + 32 * ks);
#pragma unroll
            for (int m = 0; m < 4; ++m) { const bf16x8 bb = *(const LAS bf16x8*)(UL + (16 * m + fr) * 1040 + (32 * ks + 8 * fq) * 2); acc[m] = __builtin_amdgcn_mfma_f32_16x16x32_bf16(a, bb, acc[m], 0, 0, 0); } }
#pragma unroll
        for (int m = 0; m < 4; ++m) *(LAS f32x4*)(SM + (16 * m + fr) * 128 + 16 * wave + 4 * fq) = acc[m];
    }
    __syncthreads();
    if (wave == 0) {
        const int p = lane; const f32x2 at = ((const f32x2*)(ws + WS_TAB))[g * 64 + p]; float hr = 0.f, hi = 0.f;
        for (int c0 = 0; c0 < 64; c0 += 16) { float sr[16], si[16];
#pragma unroll
            for (int j = 0; j < 16; ++j) { sr[j] = SM[(c0 + j) * 128 + p]; si[j] = SM[(c0 + j) * 128 + 64 + p]; }
            asm volatile("s_waitcnt lgkmcnt(0)" ::: "memory");
#pragma unroll
            for (int j = 0; j < 16; ++j) { LAS bf16_t* hrow = (LAS bf16_t*)(HM + (c0 + j) * 272); hrow[p] = (bf16_t)f2bf(hr); hrow[64 + p] = (bf16_t)f2bf(hi);
                const float nr = at.x * hr - at.y * hi + sr[j], ni = at.x * hi + at.y * hr + si[j]; hr = nr; hi = ni; } }
    }
    __syncthreads();
    {
#define SSM_T(tt) ((tt) == 0 ? wave : (tt) == 1 ? 15 - wave : (tt) == 2 ? 16 + wave : 31 - wave)
        const bf16_t* w3 = (const bf16_t*)(ws + WS_SWC) + (size_t)g * 512 * 128 + 8 * fq;
        const bf16_t* kt = (const bf16_t*)(ws + WS_TAB + 65536) + (size_t)g * 33 * 256 + (1 - (fq >> 1)) * 256 + fr * 16 + 8 * (fq & 1);
        f32x4 acc[4][4];
#pragma unroll
        for (int tt = 0; tt < 4; ++tt)
#pragma unroll
            for (int m = 0; m < 4; ++m) acc[tt][m] = (f32x4){0.f, 0.f, 0.f, 0.f};
        const int ksmax = (31 - wave) >> 1;
        bf16x8 an[4];
#pragma unroll
        for (int tt = 0; tt < 4; ++tt) an[tt] = *(const GAS bf16x8*)(kt + SSM_T(tt) * 256);
        for (int ks = 0; ks <= ksmax; ++ks) { bf16x8 bb[4], ac[4];
#pragma unroll
            for (int tt = 0; tt < 4; ++tt) ac[tt] = an[tt];
#pragma unroll
            for (int tt = 0; tt < 4; ++tt) { const int t = SSM_T(tt); if (ks + 1 <= (t >> 1)) an[tt] = *(const GAS bf16x8*)(kt + (t - 2 * (ks + 1)) * 256); }
#pragma unroll
            for (int m = 0; m < 4; ++m) bb[m] = *(const LAS bf16x8*)(UL + (16 * m + fr) * 1040 + (32 * ks + 8 * fq) * 2);
#pragma unroll
            for (int tt = 0; tt < 4; ++tt) { const int t = SSM_T(tt);
                if (ks <= (t >> 1)) {
#pragma unroll
                    for (int m = 0; m < 4; ++m) acc[tt][m] = __builtin_amdgcn_mfma_f32_16x16x32_bf16(ac[tt], bb[m], acc[tt][m], 0, 0, 0); } } }
#pragma unroll
        for (int j = 0; j < 4; ++j) { bf16x8 bb[4];
#pragma unroll
            for (int m = 0; m < 4; ++m) bb[m] = *(const LAS bf16x8*)(HM + (16 * m + fr) * 272 + (32 * j + 8 * fq) * 2);
#pragma unroll
            for (int tt = 0; tt < 4; ++tt) { const int t = SSM_T(tt); const bf16x8 a = *(const GAS bf16x8*)(w3 + (size_t)(16 * t + fr) * 128 + 32 * j);
#pragma unroll
                for (int m = 0; m < 4; ++m) acc[tt][m] = __builtin_amdgcn_mfma_f32_16x16x32_bf16(a, bb[m], acc[tt][m], 0, 0, 0); } }
        bf16_t* GY = (bf16_t*)(ws + WS_GY);
#pragma unroll
        for (int tt = 0; tt < 4; ++tt) { const int t = SSM_T(tt);
#pragma unroll
            for (int m = 0; m < 4; ++m) { const int tok = b * 2048 + (16 * m + fr) * 32 + t; const f32x4 v = acc[tt][m];
                u32x2 o; o.x = pk2(gelu_tanh_f(v[0]), gelu_tanh_f(v[1])); o.y = pk2(gelu_tanh_f(v[2]), gelu_tanh_f(v[3]));
                *(GAS u32x2*)(GY + (size_t)tok * DSSM + 16 * g + 4 * fq) = o; } }
#undef SSM_T
    }
    __syncthreads();
}

__device__ __forceinline__ int crow(int r, int hi) { return (r & 3) + 8 * (r >> 2) + 4 * hi; }
__device__ __forceinline__ void attn_qt(int it, int wave, int sb, int& pat, int& r, int& dil, int& lq0, int& n) {
    const int qi = wave + 8 * it, idx = qi & 15; pat = qi >> 4;
    if (pat == 0) { dil = 1; r = 0; lq0 = 512 * sb + 32 * idx; } else if (pat == 1) { dil = 4; r = idx & 3; lq0 = 128 * sb + 32 * (idx >> 2); } else { dil = 16; r = idx; lq0 = 32 * sb; }
    const int kt0 = lq0 >= 128 ? lq0 - 128 : 0; n = ((lq0 - kt0) >> 5) + 1;
}
__device__ __forceinline__ void attn_unit(unsigned char* ws, unsigned* ctl, LAS unsigned char* lds, int bh, int sb, int tid, int wave, int lane) {
    asm volatile("" : "+v"(lane), "+v"(tid));
    const int b = bh >> 4, h = bh & 15, r32 = lane & 31, hi = lane >> 5;
    const bf16_t* Qh = (const bf16_t*)(ws + WS_QH) + (size_t)bh * 2048 * 64;
    const bf16_t* Kh = (const bf16_t*)(ws + WS_KH) + (size_t)bh * 2048 * 64;
    const bf16_t* Vh = (const bf16_t*)(ws + WS_VH) + (size_t)bh * 2048 * 64;
    LAS unsigned char* vbuf = lds + wave * 12288;
    LAS float* scr = (LAS float*)(lds + 98304 + wave * 256);
    bf16_t* OP = (bf16_t*)(ws + WS_OP); LAS float* lsel = (LAS float*)(lds + 100352);
    const float slope2 = exp2f(-0.5f * (float)(h + 1)) * LOG2E;
    const int trq = (lane & 15) >> 2, trp = lane & 3, trblk = (lane >> 4) & 1;
    const int troff = (4 * hi + trq) * 192 + (16 * trblk + 4 * trp) * 2;
    const int rq = r32 - 4 * hi, self_hi = (r32 >> 2) & 1;
    int lit = 0, lj = 0, lpat, lr, ldil, llq0, ln; attn_qt(0, wave, sb, lpat, lr, ldil, llq0, ln); (void)lpat;
    int cit = 0, cj = 0, pat, r, dil, lq0, n; attn_qt(0, wave, sb, pat, r, dil, lq0, n);
    bf16x8 kA[4], kB[4], kC[4]; u32x4 vA[4], vB[4], vC[4]; bf16x8 qf[4];
    f32x16 o0, o1; float ls = 0.f, ref = 0.f; int vpar = 0;
#define AT_LDQ(dst, r_, dil_, lq0_) do { const int tq_ = (r_) + (dil_) * ((lq0_) + r32); _Pragma("unroll") for (int s = 0; s < 4; ++s) dst[s] = *(const GAS bf16x8*)(Qh + (size_t)tq_ * 64 + 16 * s + 8 * hi); } while (0)
#define AT_LOADJOB(KS, VS) do { if (lit < 6) { const int lk0_ = llq0 - 32 * lj; const int tk_ = lr + ldil * (lk0_ + r32); \
        _Pragma("unroll") for (int s = 0; s < 4; ++s) KS[s] = *(const GAS bf16x8*)(Kh + (size_t)tk_ * 64 + 16 * s + 8 * hi); \
        _Pragma("unroll") for (int j_ = 0; j_ < 4; ++j_) { const int ix_ = lane + 64 * j_; const int tkv_ = lr + ldil * (lk0_ + (ix_ >> 3)); VS[j_] = *(const GAS u32x4*)(Vh + (size_t)tkv_ * 64 + (ix_ & 7) * 8); } \
        if (++lj == ln) { lj = 0; if (++lit < 6) attn_qt(lit, wave, sb, lpat, lr, ldil, llq0, ln); } } } while (0)
#define AT_COMPJOB(KS, VS) do { \
        if (cj == 0) { _Pragma("unroll") for (int e = 0; e < 16; ++e) { o0[e] = 0.f; o1[e] = 0.f; } ls = 0.f; } \
        LAS unsigned char* vb_ = vbuf + vpar * 6144; vpar ^= 1; \
        _Pragma("unroll") for (int j_ = 0; j_ < 4; ++j_) { const int ix_ = lane + 64 * j_; *(LAS u32x4*)(vb_ + (ix_ >> 3) * 192 + (ix_ & 7) * 16) = VS[j_]; } \
        f32x16 a_; _Pragma("unroll") for (int e = 0; e < 16; ++e) a_[e] = 0.f; \
        _Pragma("unroll") for (int s = 0; s < 4; ++s) a_ = __builtin_amdgcn_mfma_f32_32x32x16_bf16(KS[s], qf[s], a_, 0, 0, 0); \
        if (cj == n - 1 && cit + 1 < 6) { int p2_, r2_, d2_, l2_, n2_; attn_qt(cit + 1, wave, sb, p2_, r2_, d2_, l2_, n2_); (void)p2_; (void)n2_; AT_LDQ(qf, r2_, d2_, l2_); }     \
        const float sl_ = slope2 * (float)dil; const int dlt_ = 32 * cj; \
        if (cj == 0) { float mine_ = 0.f; _Pragma("unroll") for (int e = 0; e < 16; ++e) { const int ce_ = (e & 3) + 8 * (e >> 2); mine_ = (ce_ == rq) ? a_[e] : mine_; } \
            const unsigned u_ = __builtin_bit_cast(unsigned, mine_); auto rr_ = __builtin_amdgcn_permlane32_swap(u_, u_, false, false); \
            ref = self_hi ? __builtin_bit_cast(float, (unsigned)rr_[1]) : __builtin_bit_cast(float, (unsigned)rr_[0]); } \
        const float b0_ = -sl_ * (float)(dlt_ + rq) - ref; float p_[16]; \
        if (dlt_ == 0) { _Pragma("unroll") for (int e = 0; e < 16; ++e) { const int ce_ = (e & 3) + 8 * (e >> 2); p_[e] = (ce_ <= rq) ? __builtin_amdgcn_exp2f(fminf(fmaf(sl_, (float)ce_, a_[e] + b0_), 100.f)) : 0.f; } } \
        else if (dlt_ == 128) { _Pragma("unroll") for (int e = 0; e < 16; ++e) { const int ce_ = (e & 3) + 8 * (e >> 2); p_[e] = (ce_ >= rq) ? __builtin_amdgcn_exp2f(fminf(fmaf(sl_, (float)ce_, a_[e] + b0_), 100.f)) : 0.f; } } \
        else { _Pragma("unroll") for (int e = 0; e < 16; ++e) { const int ce_ = (e & 3) + 8 * (e >> 2); p_[e] = __builtin_amdgcn_exp2f(fminf(fmaf(sl_, (float)ce_, a_[e] + b0_), 100.f)); } } \
        _Pragma("unroll") for (int e = 0; e < 16; ++e) ls += p_[e]; \
        u32x4 w0_, w1_; w0_.x = pk2(p_[0], p_[1]); w0_.y = pk2(p_[2], p_[3]); w0_.z = pk2(p_[4], p_[5]); w0_.w = pk2(p_[6], p_[7]); \
        w1_.x = pk2(p_[8], p_[9]); w1_.y = pk2(p_[10], p_[11]); w1_.z = pk2(p_[12], p_[13]); w1_.w = pk2(p_[14], p_[15]); \
        const bf16x8 pa0_ = __builtin_bit_cast(bf16x8, w0_), pa1_ = __builtin_bit_cast(bf16x8, w1_); \
        asm volatile("s_waitcnt lgkmcnt(0)" ::: "memory"); \
        _Pragma("unroll") for (int s = 0; s < 2; ++s) _Pragma("unroll") for (int dn = 0; dn < 2; ++dn) { \
            const s16x4 t0_ = __builtin_bit_cast(s16x4, __builtin_amdgcn_ds_read_tr16_b64_v4i16((LAS s16x4*)(vb_ + troff + (16 * s) * 192 + 64 * dn))); \
            const s16x4 t1_ = __builtin_bit_cast(s16x4, __builtin_amdgcn_ds_read_tr16_b64_v4i16((LAS s16x4*)(vb_ + troff + (16 * s + 8) * 192 + 64 * dn))); \
            const bf16x8 vf_ = (bf16x8){t0_[0], t0_[1], t0_[2], t0_[3], t1_[0], t1_[1], t1_[2], t1_[3]}; \
            if (dn == 0) o0 = __builtin_amdgcn_mfma_f32_32x32x16_bf16(vf_, s == 0 ? pa0_ : pa1_, o0, 0, 0, 0);     \
            else o1 = __builtin_amdgcn_mfma_f32_32x32x16_bf16(vf_, s == 0 ? pa0_ : pa1_, o1, 0, 0, 0); } \
        if (++cj == n) {     \
            const float l_ = shx_sum<32>(ls), li_ = 1.f / l_; \
            if (hi == 0) lsel[pat * 512 + r + dil * (lq0 + r32) - 512 * sb] = ref + log2f(l_);     \
            _Pragma("unroll") for (int j_ = 0; j_ < 4; ++j_) { u32x2 wa_, wb_; \
                wa_.x = pk2(o0[4 * j_] * li_, o0[4 * j_ + 1] * li_); wa_.y = pk2(o0[4 * j_ + 2] * li_, o0[4 * j_ + 3] * li_); \
                wb_.x = pk2(o1[4 * j_] * li_, o1[4 * j_ + 1] * li_); wb_.y = pk2(o1[4 * j_ + 2] * li_, o1[4 * j_ + 3] * li_); \
                *(LAS u32x2*)(vbuf + r32 * 144 + 16 * j_ + 8 * hi) = wa_; *(LAS u32x2*)(vbuf + r32 * 144 + 64 + 16 * j_ + 8 * hi) = wb_; } \
            asm volatile("s_waitcnt lgkmcnt(0)" ::: "memory"); \
            _Pragma("unroll") for (int i_ = 0; i_ < 4; ++i_) { const int qi_ = (lane >> 3) + 8 * i_; const u32x4 v_ = *(const LAS u32x4*)(vbuf + qi_ * 144 + (lane & 7) * 16); \
                *(GAS u32x4*)(OP + ((size_t)pat * NTOK + b * 2048 + r + dil * (lq0 + qi_)) * DATT + h * 64 + (lane & 7) * 8) = v_; } \
            asm volatile("s_waitcnt lgkmcnt(0)" ::: "memory"); \
            cj = 0; if (++cit < 6) attn_qt(cit, wave, sb, pat, r, dil, lq0, n); } } while (0)
    AT_LDQ(qf, r, dil, lq0);
    AT_LOADJOB(kA, vA); AT_LOADJOB(kB, vB); AT_LOADJOB(kC, vC);
    while (cit < 6) {
        AT_COMPJOB(kA, vA); AT_LOADJOB(kA, vA); if (cit >= 6) break;
        AT_COMPJOB(kB, vB); AT_LOADJOB(kB, vB); if (cit >= 6) break;
        AT_COMPJOB(kC, vC); AT_LOADJOB(kC, vC);
    }
#undef AT_LDQ
#undef AT_LOADJOB
#undef AT_COMPJOB
    __syncthreads();
    {
        const int c = tid & 7; bf16_t* mgb = (bf16_t*)(ws + WS_MG);
#pragma unroll 2
        for (int it = 0; it < 8; ++it) { const int tok = b * 2048 + 512 * sb + 64 * it + (tid >> 3);
            const int ql = 64 * it + (tid >> 3); const float l0 = lsel[ql], l1 = lsel[512 + ql], l2 = lsel[1024 + ql];
            const u32x4 a = *(const GAS u32x4*)(OP + ((size_t)0 * NTOK + tok) * DATT + h * 64 + 8 * c), bq = *(const GAS u32x4*)(OP + ((size_t)1 * NTOK + tok) * DATT + h * 64 + 8 * c),
                        cq = *(const GAS u32x4*)(OP + ((size_t)2 * NTOK + tok) * DATT + h * 64 + 8 * c);
            const float lm = fmaxf(l0, fmaxf(l1, l2)); float w0 = exp2f(l0 - lm), w1 = exp2f(l1 - lm), w2 = exp2f(l2 - lm); const float wi = 1.f / (w0 + w1 + w2); w0 *= wi; w1 *= wi; w2 *= wi;
            float ssq = 0.f; u32x4 o;
#pragma unroll
            for (int e = 0; e < 4; ++e) { const float lo = w0 * bflo(a[e]) + w1 * bflo(bq[e]) + w2 * bflo(cq[e]), hv = w0 * bfhi(a[e]) + w1 * bfhi(bq[e]) + w2 * bfhi(cq[e]); ssq += lo * lo + hv * hv; o[e] = pk2(lo, hv); }
            *(GAS u32x4*)(mgb + (size_t)tok * DM + 1024 + h * 64 + 8 * c) = o;
            ssq = shx_sum<1>(ssq); ssq = shx_sum<2>(ssq); ssq = shx_sum<4>(ssq);
            if (c == 0) ((float*)(ws + WS_PART))[PART_SA + (size_t)h * NTOK + tok] = ssq; }
    }
    __syncthreads();
}

constexpr size_t LIST_STRIDE = 2162688;
constexpr size_t WS_LTOK = WS_LIST, WS_LW = WS_LIST + LIST_STRIDE, WS_LSLOT = WS_LIST + 2 * LIST_STRIDE;
static_assert(WS_LSLOT + LIST_STRIDE <= WS_H1, "lists");

__device__ __forceinline__ void router_prep(const float* wr, bf16_t* wrh, bf16_t* wrl, int gt, int NGT) {
    for (int i = gt; i < 64 * 256; i += NGT) { const int e = i >> 8, k0 = (i & 255) * 8; float v[8]; unsigned h[8], l[8];
#pragma unroll
        for (int j = 0; j < 8; ++j) { v[j] = wr[(size_t)(k0 + j) * 64 + e]; h[j] = f2bf(v[j]); l[j] = f2bf(v[j] - __builtin_bit_cast(float, h[j] << 16)); }
        u32x4 oh, ol; oh.x = h[0] | (h[1] << 16); oh.y = h[2] | (h[3] << 16); oh.z = h[4] | (h[5] << 16); oh.w = h[6] | (h[7] << 16);
        ol.x = l[0] | (l[1] << 16); ol.y = l[2] | (l[3] << 16); ol.z = l[4] | (l[5] << 16); ol.w = l[6] | (l[7] << 16);
        *(GAS u32x4*)(wrh + (size_t)e * DM + k0) = oh; *(GAS u32x4*)(wrl + (size_t)e * DM + k0) = ol; }
}

__device__ __forceinline__ void route_unit(const Args& args, unsigned char* ws, unsigned* ctl, LAS unsigned char* lds, int unit, int tid, int wave, int lane) {
    const int fr = lane & 15, fq = lane >> 4, tok0 = unit * 32;
    LAS f32x2* stats = (LAS f32x2*)lds;
    LAS float* part = (LAS float*)(lds + 1024);
    LAS float* sel = (LAS float*)(lds + 1024 + 65536);
    LAS float* sc = sel + 2048;
    LAS float* msk = sc + 2048;
    LAS int* lcnt = (LAS int*)(msk + 2048);
    LAS int* lbase = lcnt + 64;
    LAS int* eidx = lbase + 64;
    LAS float* ew = (LAS float*)(eidx + 256);
    LAS int* epos = (LAS int*)(ew + 256);
    const bf16_t* pre1 = (const bf16_t*)(ws + WS_PRE1);
    if (tid < 64) lcnt[tid] = 0;
    __syncthreads();
    { const float* gp = (const float*)(ws + WS_PART); const int t = tid & 31, i = tid >> 5;
      const float a0 = gp[PART_LS + (size_t)i * NTOK + tok0 + t], a1 = gp[PART_LS + (size_t)(i + 16) * NTOK + tok0 + t];
      const float q0 = gp[PART_LQ + (size_t)i * NTOK + tok0 + t], q1 = gp[PART_LQ + (size_t)(i + 16) * NTOK + tok0 + t];
      part[i * 32 + t] = a0; part[(i + 16) * 32 + t] = a1; part[(32 + i) * 32 + t] = q0; part[(48 + i) * 32 + t] = q1; }
    __syncthreads();
    if (tid < 32) { float su = 0.f, sq = 0.f;
#pragma unroll 8
        for (int i = 0; i < 32; ++i) { su += part[i * 32 + tid]; sq += part[(32 + i) * 32 + tid]; }
        const float mean = su * (1.f / DM);
        stats[tid] = (f32x2){mean, rsqrtf(fmaxf(sq * (1.f / DM) - mean * mean, 0.f) + EPS)}; }
    __syncthreads();
    {
        const bf16_t* wrh = (const bf16_t*)(ws + WS_WR); const bf16_t* wrl = wrh + 64 * DM; bf16_t* h1 = (bf16_t*)(ws + WS_H1); unsigned char* h1f = ws + WS_H1F;
        const float* g1 = args.in[14]; const float* b1 = args.in[15];
        f32x4 acc[2][4];
#pragma unroll
        for (int m = 0; m < 2; ++m)
#pragma unroll
            for (int n = 0; n < 4; ++n) acc[m][n] = (f32x4){0.f, 0.f, 0.f, 0.f};
        const f32x2 st0 = stats[fr], st1 = stats[16 + fr];
        u32x4 nx[2]; bf16x8 nwh[4], nwl[4];
#define P5_LOAD(ks_) do { const int k_ = 256 * wave + 32 * (ks_) + 8 * fq; \
            _Pragma("unroll") for (int m = 0; m < 2; ++m) { const size_t off_ = (size_t)(tok0 + 16 * m + fr) * DM + k_; nx[m] = *(const GAS u32x4*)(pre1 + off_); } \
            _Pragma("unroll") for (int n = 0; n < 4; ++n) { nwh[n] = *(const GAS bf16x8*)(wrh + (size_t)(16 * n + fr) * DM + k_); nwl[n] = *(const GAS bf16x8*)(wrl + (size_t)(16 * n + fr) * DM + k_); } } while (0)
        P5_LOAD(0);
#pragma unroll 1
        for (int ks = 0; ks < 8; ++ks) { const int k = 256 * wave + 32 * ks + 8 * fq;
            const f32x4 ga = *(const GAS f32x4*)(g1 + k), gb = *(const GAS f32x4*)(g1 + k + 4), ba = *(const GAS f32x4*)(b1 + k), bb = *(const GAS f32x4*)(b1 + k + 4); u32x4 x_[2]; bf16x8 wh_[4], wl_[4];
#pragma unroll
            for (int m = 0; m < 2; ++m) x_[m] = nx[m];
#pragma unroll
            for (int n = 0; n < 4; ++n) { wh_[n] = nwh[n]; wl_[n] = nwl[n]; }
            if (ks + 1 < 8) P5_LOAD(ks + 1);
            bf16x8 ahi[2], alo[2];
#pragma unroll
            for (int m = 0; m < 2; ++m) { const f32x2 st = m == 0 ? st0 : st1; const size_t off = (size_t)(tok0 + 16 * m + fr) * DM + k;
                const f32x4 xa = (f32x4){bflo(x_[m][0]), bfhi(x_[m][0]), bflo(x_[m][1]), bfhi(x_[m][1])}, xb = (f32x4){bflo(x_[m][2]), bfhi(x_[m][2]), bflo(x_[m][3]), bfhi(x_[m][3])};
                const f32x4 ha = (xa - st.x) * st.y * ga + ba, hb = (xb - st.x) * st.y * gb + bb;
                u32x4 oh, ol;
                oh.x = pk2(ha[0], ha[1]); oh.y = pk2(ha[2], ha[3]); oh.z = pk2(hb[0], hb[1]); oh.w = pk2(hb[2], hb[3]);
                ol.x = pk2(ha[0] - bflo(oh.x), ha[1] - bfhi(oh.x)); ol.y = pk2(ha[2] - bflo(oh.y), ha[3] - bfhi(oh.y));
                ol.z = pk2(hb[0] - bflo(oh.z), hb[1] - bfhi(oh.z)); ol.w = pk2(hb[2] - bflo(oh.w), hb[3] - bfhi(oh.w));
                { u32x2 o8; o8.x = pk4_fp8(ha[0], ha[1], ha[2], ha[3]); o8.y = pk4_fp8(hb[0], hb[1], hb[2], hb[3]); *(GAS u32x2*)(h1f + off) = o8; }
                *(GAS u32x4*)(h1 + off) = oh; ahi[m] = __builtin_bit_cast(bf16x8, oh); alo[m] = __builtin_bit_cast(bf16x8, ol); }
#pragma unroll
            for (int n = 0; n < 4; ++n) {
#pragma unroll
                for (int m = 0; m < 2; ++m) { acc[m][n] = __builtin_amdgcn_mfma_f32_16x16x32_bf16(wh_[n], ahi[m], acc[m][n], 0, 0, 0);
                    acc[m][n] = __builtin_amdgcn_mfma_f32_16x16x32_bf16(wh_[n], alo[m], acc[m][n], 0, 0, 0); acc[m][n] = __builtin_amdgcn_mfma_f32_16x16x32_bf16(wl_[n], ahi[m], acc[m][n], 0, 0, 0); } } }
#undef P5_LOAD
#pragma unroll
        for (int m = 0; m < 2; ++m)
#pragma unroll
            for (int n = 0; n < 4; ++n) *(LAS f32x4*)(part + (wave * 32 + 16 * m + fr) * 64 + 16 * n + 4 * fq) = acc[m][n];
    }
    __syncthreads();
    {
        const int i4 = tid * 4; f32x4 s = (f32x4){0.f, 0.f, 0.f, 0.f};
#pragma unroll
        for (int w = 0; w < 8; ++w) s += *(const LAS f32x4*)(part + w * 2048 + i4);
        const f32x4 bias = *(const GAS f32x4*)(args.in[17] + (i4 & 63)); f32x4 scv, sev;
#pragma unroll
        for (int j = 0; j < 4; ++j) { scv[j] = 1.f / (1.f + expf(-s[j])); sev[j] = scv[j] + bias[j]; }
        *(LAS f32x4*)(sc + i4) = scv; *(LAS f32x4*)(sel + i4) = sev;
    }
    __syncthreads();
    {
        const int e = lane, g = e >> 3, li = e & 7; float sv[4], scv[4], gs[4]; bool keep[4];
#pragma unroll
        for (int rr = 0; rr < 4; ++rr) { sv[rr] = sel[(4 * wave + rr) * 64 + e]; scv[rr] = sc[(4 * wave + rr) * 64 + e]; }
#pragma unroll
        for (int rr = 0; rr < 4; ++rr) { float m1 = sv[rr];
            m1 = shx_max<1>(m1); m1 = shx_max<2>(m1); m1 = shx_max<4>(m1);
            const unsigned long long bm = __ballot(sv[rr] == m1); const int first = __builtin_ctz((unsigned)((bm >> (g * 8)) & 0xffull));
            float m2 = (li == first) ? -INFINITY : sv[rr];
            m2 = shx_max<1>(m2); m2 = shx_max<2>(m2); m2 = shx_max<4>(m2);
            gs[rr] = m1 + m2; keep[rr] = false; }
        bool gtaken[4] = {false, false, false, false};
#pragma unroll
        for (int round = 0; round < 4; ++round)
#pragma unroll
            for (int rr = 0; rr < 4; ++rr) { const float cur = gtaken[rr] ? -INFINITY : gs[rr], mx = wave_max_f(cur);
                const unsigned long long bm = __ballot(cur == mx); const int gsel = (int)(__builtin_ctzll(bm) >> 3);
                if (g == gsel) { gtaken[rr] = true; keep[rr] = true; } }
        bool taken[4] = {false, false, false, false}; int rank[4] = {-1, -1, -1, -1};
#pragma unroll
        for (int round = 0; round < 8; ++round)
#pragma unroll
            for (int rr = 0; rr < 4; ++rr) { const float cur = (keep[rr] && !taken[rr]) ? sv[rr] : -INFINITY, mx = wave_max_f(cur);
                const unsigned long long bm = __ballot(cur == mx); const int f = (int)__builtin_ctzll(bm);
                if (e == f) { taken[rr] = true; rank[rr] = round; } }
#pragma unroll
        for (int rr = 0; rr < 4; ++rr) { const int row = 4 * wave + rr; const bool selected = rank[rr] >= 0;
            const float wsum = wave_sum_f(selected ? scv[rr] : 0.f);
            if (selected) { const int lp = __hip_atomic_fetch_add(&lcnt[e], 1, __ATOMIC_RELAXED, __HIP_MEMORY_SCOPE_WORKGROUP); eidx[row * 8 + rank[rr]] = e; ew[row * 8 + rank[rr]] = scv[rr] / wsum * 2.5f; epos[row * 8 + rank[rr]] = lp; } }
    }
    __syncthreads();
    if (tid < 64) { const int c = lcnt[tid]; lbase[tid] = c > 0 ? atomicAdd((int*)(ctl + CW_CNT) + tid, c) : 0; }
    __syncthreads();
    int* ltok = (int*)(ws + WS_LTOK); float* lw = (float*)(ws + WS_LW); int* lslot = (int*)(ws + WS_LSLOT);
    if (tid < 256) { const int row = tid >> 3, k = tid & 7, e = eidx[tid], pos = lbase[e] + epos[tid], tok = tok0 + row;
        ltok[e * CAP + pos] = tok; lw[e * CAP + pos] = ew[tid]; lslot[e * CAP + pos] = tok * 9 + k; }
    else if (tid < 288) { const int tok = tok0 + (tid - 256); ltok[NEXP * CAP + tok] = tok; lw[NEXP * CAP + tok] = 1.f; lslot[NEXP * CAP + tok] = tok * 9 + 8; }
    if (unit == 0 && tid == 300) ((int*)(ctl + CW_CNT))[NEXP] = NTOK;
    __syncthreads();
}

constexpr int MOE_DESC_OFF = MISC_OFF + 256, MOE_RTAB_OFF = MISC_OFF + 1024, MOE_TMP_OFF = MISC_OFF + 1024 + 13312;
template <int NT, bool GATHER>
__device__ __forceinline__ void moe_setup(unsigned char* ws, unsigned* ctl, LAS unsigned char* lds, int vcu, int G, int tid) {
    LAS int* desc = (LAS int*)(lds + MOE_DESC_OFF); LAS unsigned* rtab = (LAS unsigned*)(lds + MOE_RTAB_OFF); LAS int* tmp = (LAS int*)(lds + MOE_TMP_OFF);
    const int* cnt = (const int*)(ctl + CW_CNT);
    if (tid < 65) tmp[tid] = __hip_atomic_load(cnt + tid, __ATOMIC_RELAXED, __HIP_MEMORY_SCOPE_AGENT);
    if (tid < 16) desc[tid * 8] = -1;
    __syncthreads();
    if (tid < 66) { int tp = 0; for (int k = 0; k < 65; ++k) { const int mt = (tmp[k] + 255) >> 8; tp += (k < tid) ? mt : 0; } tmp[128 + tid] = tp * NT; tmp[256 + tid] = tp * 256; }
    __syncthreads();
    if (tid < 65) { const int t0 = tmp[128 + tid], t1 = tmp[128 + tid + 1], ce = tmp[tid], rb = tmp[256 + tid];
        for (int i = 0; i < 16; ++i) { const int L = i * G + vcu;
            if (L >= t0 && L < t1) { const int local = L - t0, mt = local / NT, nt = local % NT, rows = ce - mt * 256;
                desc[i * 8 + 0] = tid; desc[i * 8 + 1] = mt; desc[i * 8 + 2] = nt; desc[i * 8 + 3] = rows < 256 ? rows : 256; desc[i * 8 + 4] = rb + mt * 256; } } }
    __syncthreads();
    if (GATHER) { const int* ltok = (const int*)(ws + WS_LTOK); unsigned v[4];
#pragma unroll
        for (int q = 0; q < 4; ++q) { const int j = tid + 512 * q, i = j >> 8, e = desc[i * 8]; int tok = 0;
            if (e >= 0) { const int idx = desc[i * 8 + 1] * 256 + (j & 255); if (idx < tmp[e]) tok = ltok[e * CAP + idx]; }
            v[q] = (unsigned)tok * (unsigned)DM; }
#pragma unroll
        for (int q = 0; q < 4; ++q) rtab[tid + 512 * q] = v[q];
        __syncthreads(); }
    else { const int* lslot = (const int*)(ws + WS_LSLOT); const float* lw = (const float*)(ws + WS_LW); LAS unsigned* stab = (LAS unsigned*)(lds + MOE_RTAB_OFF); int sl[7]; float w[7];
#pragma unroll
        for (int q = 0; q < 7; ++q) { const int j = tid + 512 * q, i = j >> 8; sl[q] = -1; w[q] = 0.f;
            if (i < 13) { const int e = desc[i * 8]; if (e >= 0) { const int idx = desc[i * 8 + 1] * 256 + (j & 255); if (idx < tmp[e]) { sl[q] = lslot[e * CAP + idx]; w[q] = lw[e * CAP + idx]; } } } }
#pragma unroll
        for (int q = 0; q < 7; ++q) { const int j = tid + 512 * q; if (j < 13 * 256) stab[j] = sl[q] < 0 ? 0u : (((unsigned)sl[q] << 15) | (f2bf(w[q] * (WUNSCALE8 * YSCALE8)) & 0x7fffu)); }
        __syncthreads(); }
}
template <bool GATHER_>
struct MoeSched {
    static constexpr bool GATHER = GATHER_;
    LAS const int* desc; LAS const unsigned* rtab; const char* A; const char* Bt; unsigned lda, ldb; int nt; size_t bexp; int lo, hi;
    __device__ __forceinline__ bool next(int i_, g8::Unit& u) const {
        const int i = i_ + lo; if (i >= hi || i >= (GATHER ? 8 : 13)) return false;
        const int e = __builtin_amdgcn_readfirstlane(desc[i * 8]); if (e < 0) return false;
        u.e = e; u.pm = __builtin_amdgcn_readfirstlane(desc[i * 8 + 1]); u.pn = __builtin_amdgcn_readfirstlane(desc[i * 8 + 2]); u.rows = __builtin_amdgcn_readfirstlane(desc[i * 8 + 3]);
        u.aux = GATHER ? i : __builtin_amdgcn_readfirstlane(desc[i * 8 + 4]); u.seg = i; return true;
    }
    __device__ __forceinline__ const char* a_base(const g8::Unit& u) const { return GATHER ? A : A + (size_t)u.aux * lda; }
    __device__ __forceinline__ const char* b_base(const g8::Unit& u) const { return Bt + (size_t)u.e * bexp + (size_t)u.pn * 256 * ldb; }
    __device__ __forceinline__ void g_off(const g8::Unit& u, int r, int cb, unsigned (&v0)[2], unsigned (&v1)[2]) const {
        LAS const unsigned* t = rtab + u.aux * 256 + r;
        v0[0] = t[0] + (unsigned)cb; v0[1] = t[64] + (unsigned)cb; v1[0] = t[128] + (unsigned)cb; v1[1] = t[192] + (unsigned)cb;
    }
};
struct EpiAct {
    static constexpr bool PERM = true;
    unsigned char* act; LAS const int* desc;
    __device__ __forceinline__ bool keep(const g8::Unit&) const { return false; }
    __device__ __forceinline__ void operator()(f32x4 (&acc)[2][2][4][2], const g8::Unit& u, int wr, int wc, int fr, int fq) const {
        asm volatile("" : "+v"(fr), "+v"(fq));
        const int rb = __builtin_amdgcn_readfirstlane(desc[u.aux * 8 + 4]); const int col = u.pn * 128 + wc * 32 + 8 * fq;
#pragma unroll
        for (int ai = 0; ai < 2; ++ai)
#pragma unroll
            for (int m = 0; m < 4; ++m) { const int rl = ai * 128 + wr * 64 + m * 16 + fr;
                if (rl < u.rows) { float y[8];
#pragma unroll
                    for (int n = 0; n < 2; ++n)
#pragma unroll
                        for (int e = 0; e < 4; ++e) { const float g = acc[ai][0][m][n][e] * WUNSCALE8; y[4 * n + e] = g * sigmoid_f(g) * (acc[ai][1][m][n][e] * WUNSCALE8); }
                    u32x2 w; w.x = pk4_fp8(y[0], y[1], y[2], y[3]); w.y = pk4_fp8(y[4], y[5], y[6], y[7]);
                    *(GAS u32x2*)(act + (size_t)(rb + rl) * DEXP + col) = w; } }
    }
};
struct EpiDown {
    static constexpr int PERM = 2;
    unsigned char* y; LAS const unsigned* stab;
    __device__ __forceinline__ bool keep(const g8::Unit&) const { return false; }
    __device__ __forceinline__ void operator()(f32x4 (&acc)[2][2][4][2], const g8::Unit& u, int wr, int wc, int fr, int fq) const {
        asm volatile("" : "+v"(fr), "+v"(fq));
#pragma unroll
        for (int ai = 0; ai < 2; ++ai)
#pragma unroll
            for (int m = 0; m < 4; ++m) { const int rl = ai * 128 + wr * 64 + m * 16 + fr;
                if (rl < u.rows) { const unsigned pk_ = stab[u.seg * 256 + rl]; const float w = __builtin_bit_cast(float, (pk_ & 0x7fffu) << 16);
                    const f32x4 a0 = acc[ai][0][m][0] * w, a1 = acc[ai][0][m][1] * w, b0 = acc[ai][1][m][0] * w, b1 = acc[ai][1][m][1] * w;
                    u32x4 o; o.x = pk4_fp8(a0[0], a0[1], a0[2], a0[3]); o.y = pk4_fp8(a1[0], a1[1], a1[2], a1[3]); o.z = pk4_fp8(b0[0], b0[1], b0[2], b0[3]); o.w = pk4_fp8(b1[0], b1[1], b1[2], b1[3]);
                    *(GAS u32x4*)(y + (size_t)(pk_ >> 15) * DM + u.pn * 256 + 16 * (4 * wc + fq)) = o; } }
    }
};
__device__ __forceinline__ float fp8lo(unsigned w, int i) { return i == 0 ? __builtin_amdgcn_cvt_f32_fp8(w, 0) : i == 1 ? __builtin_amdgcn_cvt_f32_fp8(w, 1) : i == 2 ? __builtin_amdgcn_cvt_f32_fp8(w, 2) : __builtin_amdgcn_cvt_f32_fp8(w, 3); }
#define P8_LOAD(Y_, HA_, HB_, tok_, j_) do { const int col_ = 16 * lane + 1024 * (j_); _Pragma("unroll") for (int k = 0; k < 9; ++k) Y_[k] = *(const GAS u32x4*)(y + (size_t)((tok_) * 9 + k) * DM + col_); \
        HA_ = *(const GAS u32x4*)(h1 + (size_t)(tok_) * DM + col_); HB_ = *(const GAS u32x4*)(h1 + (size_t)(tok_) * DM + col_ + 8); } while (0)
#define P8_PROC(Y_, HA_, HB_, vj_) do { float a_[16]; _Pragma("unroll") for (int e = 0; e < 16; ++e) a_[e] = 0.f; \
        _Pragma("unroll") for (int k = 0; k < 9; ++k) _Pragma("unroll") for (int e = 0; e < 4; ++e) { const unsigned w_ = Y_[k][e]; a_[4 * e] += fp8lo(w_, 0); a_[4 * e + 1] += fp8lo(w_, 1); a_[4 * e + 2] += fp8lo(w_, 2); a_[4 * e + 3] += fp8lo(w_, 3); } \
        _Pragma("unroll") for (int e = 0; e < 4; ++e) { vj_[2 * e] = ALPHA * bflo(HA_[e]) + YUNSCALE8 * a_[2 * e]; vj_[2 * e + 1] = ALPHA * bfhi(HA_[e]) + YUNSCALE8 * a_[2 * e + 1]; \
            vj_[8 + 2 * e] = ALPHA * bflo(HB_[e]) + YUNSCALE8 * a_[8 + 2 * e]; vj_[8 + 2 * e + 1] = ALPHA * bfhi(HB_[e]) + YUNSCALE8 * a_[8 + 2 * e + 1]; } } while (0)
__device__ __forceinline__ void final_rows(const Args& args, unsigned char* ws, LAS unsigned char* lds, int wave, int gw, int NGW, int lane) {
    LAS float* obuf = (LAS float*)(lds + wave * 8192);
    const bf16_t* h1 = (const bf16_t*)(ws + WS_H1); const unsigned char* y = ws + WS_Y; const float* g2 = args.in[24]; const float* b2 = args.in[25];
    u32x4 ya[9], yb[9], haa, hba, hab, hbb;
    int tok = gw;
    if (tok < NTOK) P8_LOAD(ya, haa, hba, tok, 0);
    for (; tok < NTOK; tok += NGW) {
        float v0[16], v1[16];
        P8_LOAD(yb, hab, hbb, tok, 1);
        P8_PROC(ya, haa, hba, v0);
        if (tok + NGW < NTOK) P8_LOAD(ya, haa, hba, tok + NGW, 0);
        P8_PROC(yb, hab, hbb, v1);
        float s = 0.f;
#pragma unroll
        for (int e = 0; e < 16; ++e) s += v0[e] + v1[e];
        const float mean = wave_sum_f(s) * (1.f / DM); float q = 0.f;
#pragma unroll
        for (int e = 0; e < 16; ++e) { v0[e] -= mean; v1[e] -= mean; q += v0[e] * v0[e] + v1[e] * v1[e]; }
        const float rstd = rsqrtf(wave_sum_f(q) * (1.f / DM) + EPS);
#pragma unroll
        for (int j = 0; j < 2; ++j) { const int col = 16 * lane + 1024 * j;
#pragma unroll
            for (int c = 0; c < 4; ++c) { const f32x4 ga = *(const GAS f32x4*)(g2 + col + 4 * c), ba = *(const GAS f32x4*)(b2 + col + 4 * c); f32x4 o;
#pragma unroll
                for (int e = 0; e < 4; ++e) o[e] = (j == 0 ? v0[4 * c + e] : v1[4 * c + e]) * rstd * ga[e] + ba[e];
                *(LAS f32x4*)(obuf + col + 4 * c) = o; } }
        asm volatile("s_waitcnt lgkmcnt(0)" ::: "memory");
#pragma unroll
        for (int i = 0; i < 8; ++i) { const f32x4 o = *(const LAS f32x4*)(obuf + 4 * lane + 256 * i); *(GAS f32x4*)(args.out + (size_t)tok * DM + 4 * lane + 256 * i) = o; }
        asm volatile("s_waitcnt lgkmcnt(0)" ::: "memory");
    }
}
#undef P8_LOAD
#undef P8_PROC

__global__ void __launch_bounds__(NWAVES * 64, 2) mega_fwd(Args args) {
    extern __shared__ __attribute__((aligned(16))) unsigned char lds_raw[];
    Frame F;
    F.lds = (LAS unsigned char*)lds_raw; F.MISC = (volatile LAS unsigned*)(F.lds + MISC_OFF);
    F.tid = threadIdx.x; F.lane = F.tid & 63; F.wave = __builtin_amdgcn_readfirstlane(F.tid >> 6);
    F.G = gridDim.x; { const int bx = blockIdx.x; F.vcu = (F.G % 8 == 0) ? (bx % 8) * (F.G / 8) + bx / 8 : bx; }
    F.ws = args.ws; F.ctl = (unsigned*)(args.ws + WS_CTL);
    unsigned char* ws = args.ws;
    for (int u = F.tid; u < (LDS_BYTES - MISC_OFF) / 4; u += NWAVES * 64) ((LAS unsigned*)(F.lds + MISC_OFF))[u] = 0u;
    __syncthreads();
    XcdBarrier bar; bar.bar = F.ctl + CW_BAR + args.pad * XCD_BAR_WORDS; bar.x = 0; bar.st = nullptr;
    if (args.use_bar) bar = xcd_barrier_post(F.ctl + CW_BAR + args.pad * XCD_BAR_WORDS, F.MISC + 8);
    const int lo = args.ph_lo, hi = args.ph_hi;
#define IN(k) (lo <= (k) && (k) < hi)
#define SEAM(k) do { if (IN(k) && IN((k) + 1)) xcd_barrier(bar, F.wave); } while (0)
    const int gw = F.vcu * NWAVES + F.wave, NGW = F.G * NWAVES;
    const int NGT = F.G * NWAVES * 64;
#define REFRESH_TID() do { F.lane = fresh_lane(); F.tid = F.wave * 64 + F.lane; } while (0)
#define GT() ((int)blockIdx.x * (NWAVES * 64) + F.tid)

    if (IN(0)) { REFRESH_TID();
        const float* x = args.in[0];
        { bf16_t* xb = (bf16_t*)(ws + WS_XB);
#pragma unroll 4
          for (int i = GT(); i < NTOK * DM / 8; i += NGT) { const f32x4 a = *(const GAS f32x4*)(x + (size_t)i * 8), b = *(const GAS f32x4*)(x + (size_t)i * 8 + 4);
              u32x4 o; o.x = pk2(a[0], a[1]); o.y = pk2(a[2], a[3]); o.z = pk2(b[0], b[1]); o.w = pk2(b[2], b[3]); *(GAS u32x4*)(xb + (size_t)i * 8) = o; } }
        constexpr int I_IN = 32 * 64, I_GLU = 16 * 32, I_OUT = 32 * 32;
        constexpr int NITEMS = I_IN + I_GLU + I_OUT;
        LAS unsigned char* tile = F.lds + F.wave * 9216;
        for (int it = gw; it < NITEMS; it += NGW) {
            int r = it;
            if (r < I_IN) { const int kb = r / 64, nb = r % 64; transpose_item(args.in[1], NPROJ, (bf16_t*)(ws + WS_WIN), DM, kb * 64, nb * 64, nb * 64, nullptr, tile, F.lane); continue; } r -= I_IN;
            if (r < I_GLU) { const int kb = r / 32, nb = r % 32, n0 = nb * 64; const int orow = n0 < 1024 ? glu_row(n0) : glu_row(n0 - 1024) + 128;
                transpose_item(args.in[10], 2048, (bf16_t*)(ws + WS_WGLU), DSSM, kb * 64, n0, orow, nullptr, tile, F.lane); continue; } r -= I_GLU;
            { const int kb = r / 32, nb = r % 32; const float* ks = kb < 16 ? args.in[11] : args.in[12] - 1024;
                transpose_item(args.in[13], DM, (bf16_t*)(ws + WS_WOUT), DM, kb * 64, nb * 64, nb * 64, ks, tile, F.lane); }
        }
    }
    if (IN(0)) router_prep(args.in[16], (bf16_t*)(ws + WS_WR), (bf16_t*)(ws + WS_WR) + 64 * DM, GT(), NGT);
    if (IN(0)) {
        __syncthreads();
        for (int it = F.vcu; it < 256; it += F.G) ssm_prep_item(args, ws, F.lds, it >> 2, it & 3, F.tid);
    }
    SEAM(0);
    if (IN(1)) { REFRESH_TID();
        EpiIn E{(bf16_t*)(ws + WS_UG)};
        volatile LAS int* qslot = (volatile LAS int*)(F.lds + MISC_OFF + 64);
        const int slot = F.vcu % 3;
        for (int part = 0; part < 3; ++part) {
            if (part == slot) { __syncthreads(); REFRESH_TID();
                if (F.tid == 0) *qslot = (int)__hip_atomic_fetch_add(F.ctl + CW_QC, 1u, __ATOMIC_RELAXED, __HIP_MEMORY_SCOPE_AGENT);
                __syncthreads();
                const int w = __builtin_amdgcn_readfirstlane(*qslot);
                if (w < NCONV_GU) f8_convert_chunk(args, ws, F.lds, 0, w, F.wave, F.lane);
                __syncthreads(); }
            const int lo = part == 0 ? 0 : part == 1 ? (slot == 1 ? 1 : 2) : 2, hi = part == 0 ? (slot == 1 ? 1 : 2) : 2;
            if (part < 2 && lo < hi) { REFRESH_TID();
                g8::DenseSched S{(const char*)(ws + WS_XB), (const char*)(ws + WS_WIN), DM * 2, DM * 2, NTOK / 256, NPROJ / 256, 1, DM / 64, F.G, F.vcu, 0u, lo, hi};
                g8::gemm_phase(F.lds, S, E, F.wave); }
        }
    }
    SEAM(1);
    if (IN(2)) { REFRESH_TID();
        constexpr int NMIX = 512, NCONV = NCONV_GU;
        volatile LAS int* qslot = (volatile LAS int*)(F.lds + MISC_OFF + 64);
        unsigned* qM = F.ctl + CW_QM; unsigned* qC = F.ctl + CW_QC;
        const bool conv_first = (F.vcu & 31) >= 22;
        for (int pass = 0; pass < 2; ++pass) {
            const bool do_conv = (pass == 0) == conv_first;
            for (;;) {
                __syncthreads();
                REFRESH_TID();
                if (F.tid == 0) *qslot = (int)__hip_atomic_fetch_add(do_conv ? qC : qM, 1u, __ATOMIC_RELAXED, __HIP_MEMORY_SCOPE_AGENT);
                __syncthreads();
                const int w = __builtin_amdgcn_readfirstlane(*qslot);
                if (w >= (do_conv ? NCONV : NMIX)) break;
                if (do_conv) {
                    f8_convert_chunk(args, ws, F.lds, 0, w, F.wave, F.lane);
                } else if (w < 256) attn_unit(ws, F.ctl, F.lds, w >> 2, w & 3, F.tid, F.wave, F.lane);
                else ssm_unit(ws, F.lds, (w - 256) >> 6, (w - 256) & 63, F.tid, F.wave, F.lane);
            }
        }
    }
    SEAM(2);
    if (IN(3)) { REFRESH_TID();
        g8::DenseSched S{(const char*)(ws + WS_GY), (const char*)(ws + WS_WGLU), DSSM * 2, DSSM * 2, NTOK / 256, 2048 / 256, 1, DSSM / 64, F.G, F.vcu, 0u, 0, 1 << 30};
        EpiGlu E{(bf16_t*)(ws + WS_MG), (float*)(ws + WS_PART) + PART_SS};
        g8::gemm_phase(F.lds, S, E, F.wave);
    }
    SEAM(3);
    if (IN(4)) { REFRESH_TID();
        g8::DenseSched S{(const char*)(ws + WS_MG), (const char*)(ws + WS_WOUT), DM * 2, DM * 2, NTOK / 256, DM / 256, 2, 1024 / 64, F.G, F.vcu, 2048u, 0, 1 << 30};
        LAS int* rpm = (LAS int*)(F.lds + MISC_OFF + 128);
        { g8::Unit u0; int pm0 = -1;
          if (S.next(0, u0)) { pm0 = u0.pm; const int row = F.tid & 255, h = F.tid >> 8; const float* part = (const float*)(ws + WS_PART) + (size_t)pm0 * 256 + row; float s = 0.f;
              if (h == 0) {
#pragma unroll
                  for (int i = 0; i < 32; ++i) s += part[PART_SS + (size_t)i * NTOK]; }
              else {
#pragma unroll
                  for (int i = 0; i < 16; ++i) s += part[PART_SA + (size_t)i * NTOK]; }
              ((LAS float*)(F.lds + MISC_OFF + 1024))[row * 2 + h] = rsqrtf(s * (1.f / 1024.f) + EPS); }
          if (F.tid == 0) *rpm = pm0; __syncthreads(); }
        EpiOut E{args.in[0], (bf16_t*)(ws + WS_PRE1), (const float*)(ws + WS_PART), (float*)(ws + WS_PART), (LAS f32x2*)(F.lds + MISC_OFF + 1024), rpm};
        g8::gemm_phase(F.lds, S, E, F.wave);
    }
    SEAM(4);
    if (IN(5)) { REFRESH_TID(); for (int u = F.vcu; u < 256; u += F.G) route_unit(args, ws, F.ctl, F.lds, u, F.tid, F.wave, F.lane); }
    SEAM(5);
    if (IN(6)) { REFRESH_TID();
        moe_setup<4, true>(ws, F.ctl, F.lds, F.vcu, F.G, F.tid);
        EpiAct E{ws + WS_ACT, (LAS const int*)(F.lds + MOE_DESC_OFF)};
        volatile LAS int* qslot = (volatile LAS int*)(F.lds + MISC_OFF + 64);
        int nun, quota, slot;
        { LAS const int* desc = (LAS const int*)(F.lds + MOE_DESC_OFF); LAS const int* tmp = (LAS const int*)(F.lds + MOE_TMP_OFF);
          int n_ = 0; for (int i = 0; i < 8; ++i) n_ += (desc[i * 8] >= 0) ? 1 : 0;
          nun = __builtin_amdgcn_readfirstlane(n_);
          const int bal = (tmp[128 + 65] + NCONV_D + F.G / 2) / F.G; quota = __builtin_amdgcn_readfirstlane(bal - nun); slot = F.vcu % (nun + 1); }
        for (int part = 0; part < 2; ++part) {
            const int lo = part == 0 ? 0 : slot, hi = part == 0 ? slot : nun;
            if (lo < hi) { REFRESH_TID();
                MoeSched<true> S{(LAS const int*)(F.lds + MOE_DESC_OFF), (LAS const unsigned*)(F.lds + MOE_RTAB_OFF), (const char*)(ws + WS_H1F), (const char*)(ws + WS_WGU), DM, DM, DM / 128, (size_t)1024 * DM, lo, hi};
                g8::gemm_phase_f8(F.lds, S, E, F.wave); }
            if (part == 0) { REFRESH_TID();
                for (; quota > 0; --quota) { __syncthreads();
                    if (F.tid == 0) *qslot = (int)__hip_atomic_fetch_add(F.ctl + CW_QD, 8u, __ATOMIC_RELAXED, __HIP_MEMORY_SCOPE_AGENT);
                    __syncthreads();
                    const int w = __builtin_amdgcn_readfirstlane(*qslot); if (w >= NSUB_D) break;
                    if (w + F.wave < NSUB_D) f8_convert_items(args, ws, F.lds, 1, (w + F.wave) * 8, F.wave, F.lane); }
                __syncthreads(); }
        }
        { REFRESH_TID();
          for (;;) { __syncthreads();
              if (F.tid == 0) *qslot = (int)__hip_atomic_fetch_add(F.ctl + CW_QD, 1u, __ATOMIC_RELAXED, __HIP_MEMORY_SCOPE_AGENT);
              __syncthreads();
              const int w = __builtin_amdgcn_readfirstlane(*qslot); if (w >= NSUB_D) break;
              f8_convert_one(args, ws, F.lds, 1, w * 8 + F.wave, F.wave, F.lane); } }
    }
    SEAM(6);
    if (IN(7)) { REFRESH_TID();
        moe_setup<8, false>(ws, F.ctl, F.lds, F.vcu, F.G, F.tid);
        MoeSched<false> S{(LAS const int*)(F.lds + MOE_DESC_OFF), (LAS const unsigned*)(F.lds + MOE_RTAB_OFF), (const char*)(ws + WS_ACT), (const char*)(ws + WS_WD), DEXP, DEXP, DEXP / 128, (size_t)DM * DEXP, 0, 13};
        EpiDown E{ws + WS_Y, (LAS const unsigned*)(F.lds + MOE_RTAB_OFF)};
        g8::gemm_phase_f8(F.lds, S, E, F.wave);
    }
    SEAM(7);
    if (IN(8)) { REFRESH_TID(); final_rows(args, ws, F.lds, F.wave, gw, NGW, F.lane); }
#undef IN
#undef SEAM
}

static int g_grid = 0;
static void launch_mega(void* const* d_in, void* d_out, void* d_ws, size_t ws_size, hipStream_t stream, int lo, int hi, int use_bar, int region = 0) {
    if (g_grid == 0) {
        int dev = 0, cus = 0, per_cu = 0;
        (void)hipGetDevice(&dev); (void)hipDeviceGetAttribute(&cus, hipDeviceAttributeMultiprocessorCount, dev);
        if (hipFuncSetAttribute((const void*)mega_fwd, hipFuncAttributeMaxDynamicSharedMemorySize, LDS_BYTES) != hipSuccess) { fprintf(stderr, "hipFuncSetAttribute failed\n"); g_grid = -1; return; }
        if (hipOccupancyMaxActiveBlocksPerMultiprocessor(&per_cu, (const void*)mega_fwd, NWAVES * 64, LDS_BYTES) != hipSuccess || per_cu < 1) { fprintf(stderr, "occupancy query: %d blocks/CU\n", per_cu); (void)hipGetLastError(); g_grid = -1; return; }
        g_grid = cus;
        if (ws_size < WS_END) { fprintf(stderr, "workspace too small: %zu < %zu\n", ws_size, (size_t)WS_END); g_grid = -1; return; }
    }
    if (g_grid < 0) return;
    Args a{};
    for (int i = 0; i < 26; ++i) a.in[i] = (const float*)d_in[i];
    a.out = (float*)d_out; a.ws = (unsigned char*)d_ws; a.ph_lo = lo; a.ph_hi = hi; a.use_bar = use_bar; a.pad = region;
    hipLaunchKernelGGL(mega_fwd, dim3(g_grid), dim3(NWAVES * 64), LDS_BYTES, stream, a);
}

extern "C" void kernel_launch(void* const* d_in, const int* in_sizes, int n_in, void* d_out, int out_size, void* d_ws, size_t ws_size, hipStream_t stream) {
    (void)in_sizes; (void)n_in; (void)out_size;
    (void)hipMemsetAsync((char*)d_ws + WS_CTL, 0, CTL_ZERO_BYTES, stream);
    launch_mega(d_in, d_out, d_ws, ws_size, stream, 0, 9, 1);
}
```

```cpp
#include <hip/hip_runtime.h>
#include <math.h>
#include <stdint.h>
#include <cstdio>

#define NTOK 8192
#define SEQ 2048
#define DM 2048
#define DSSM 1024
#define DATT 1024
#define NPROJ 4096
#define NEXP 64
#define DEXP 512
#define CAP 8192
#define ALPHA 1.189207115002721f
#define EPS 1e-5f

#define GAS __attribute__((address_space(1)))
#define LAS __attribute__((address_space(3)))
typedef unsigned short bf16_t;
typedef short bf16x8 __attribute__((ext_vector_type(8)));
typedef short s16x4 __attribute__((ext_vector_type(4)));
typedef float f32x4 __attribute__((ext_vector_type(4)));
typedef float f32x2 __attribute__((ext_vector_type(2)));
typedef float f32x16 __attribute__((ext_vector_type(16)));
typedef unsigned u32x4 __attribute__((ext_vector_type(4)));
typedef unsigned u32x2 __attribute__((ext_vector_type(2)));
typedef GAS unsigned gu32;
typedef int i32x8 __attribute__((ext_vector_type(8)));

constexpr float C2Q = 0.125f * 1.4426950408889634f;
constexpr float LOG2E = 1.4426950408889634f;

__device__ __forceinline__ unsigned f2bf(float f) { unsigned u = __builtin_bit_cast(unsigned, f); return (u + 0x7fffu + ((u >> 16) & 1u)) >> 16; }
typedef __bf16 hwbf16x2 __attribute__((ext_vector_type(2)));
__device__ __forceinline__ unsigned pk2(float lo, float hi) { f32x2 v = {lo, hi}; hwbf16x2 b = __builtin_convertvector(v, hwbf16x2); return __builtin_bit_cast(unsigned, b); }
__device__ __forceinline__ unsigned pk4_fp8(float a, float b, float c, float d) { int w = 0; w = __builtin_amdgcn_cvt_pk_fp8_f32(a, b, w, false); w = __builtin_amdgcn_cvt_pk_fp8_f32(c, d, w, true); return (unsigned)w; }
typedef short s16x2_t __attribute__((ext_vector_type(2)));
__device__ __forceinline__ unsigned pk4_fp8_bf16(unsigned lo2, unsigned hi2, float scale) { s16x2_t w = {0, 0};
    w = __builtin_amdgcn_cvt_scalef32_pk_fp8_bf16(w, __builtin_bit_cast(hwbf16x2, lo2), scale, false); w = __builtin_amdgcn_cvt_scalef32_pk_fp8_bf16(w, __builtin_bit_cast(hwbf16x2, hi2), scale, true); return __builtin_bit_cast(unsigned, w); }
__device__ __forceinline__ float bf2f(unsigned short b) { return __builtin_bit_cast(float, (unsigned)b << 16); }
__device__ __forceinline__ float bflo(unsigned w) { return __builtin_bit_cast(float, w << 16); }
__device__ __forceinline__ float bfhi(unsigned w) { return __builtin_bit_cast(float, w & 0xffff0000u); }
__device__ __forceinline__ float gelu_tanh_f(float x) { const float u = 0.7978845608028654f * (x + 0.044715f * x * x * x); const float e = __expf(2.f * u); return x * (1.f - __builtin_amdgcn_rcpf(e + 1.f)); }
__device__ __forceinline__ float sigmoid_f(float x) { return __builtin_amdgcn_rcpf(1.f + __expf(-x)); }
__device__ __forceinline__ int fresh_lane() { int l = (int)__builtin_amdgcn_mbcnt_hi(~0u, __builtin_amdgcn_mbcnt_lo(~0u, 0u)); asm volatile("" : "+v"(l)); return l; }
template <int K> __device__ __forceinline__ float shx(float v) {
    if constexpr (K < 32) return __builtin_bit_cast(float, __builtin_amdgcn_ds_swizzle(__builtin_bit_cast(int, v), (K << 10) | 0x1f));
    else { const unsigned u = __builtin_bit_cast(unsigned, v); auto rr = __builtin_amdgcn_permlane32_swap(u, u, false, false);
        const float a = __builtin_bit_cast(float, (unsigned)rr[0]), b = __builtin_bit_cast(float, (unsigned)rr[1]);
        return (int)__builtin_amdgcn_mbcnt_hi(~0u, __builtin_amdgcn_mbcnt_lo(~0u, 0u)) < 32 ? b : a; }
}
template <int K> __device__ __forceinline__ float shx_sum(float v) {
    if constexpr (K < 32) return v + shx<K>(v);
    else { const unsigned u = __builtin_bit_cast(unsigned, v); auto rr = __builtin_amdgcn_permlane32_swap(u, u, false, false); return __builtin_bit_cast(float, (unsigned)rr[0]) + __builtin_bit_cast(float, (unsigned)rr[1]); }
}
template <int K> __device__ __forceinline__ float shx_max(float v) {
    if constexpr (K < 32) return fmaxf(v, shx<K>(v));
    else { const unsigned u = __builtin_bit_cast(unsigned, v); auto rr = __builtin_amdgcn_permlane32_swap(u, u, false, false); return fmaxf(__builtin_bit_cast(float, (unsigned)rr[0]), __builtin_bit_cast(float, (unsigned)rr[1])); }
}
__device__ __forceinline__ float wave_max_f(float v) { v = shx_max<1>(v); v = shx_max<2>(v); v = shx_max<4>(v); v = shx_max<8>(v); v = shx_max<16>(v); return shx_max<32>(v); }
__device__ __forceinline__ float wave_sum_f(float v) { v = shx_sum<1>(v); v = shx_sum<2>(v); v = shx_sum<4>(v); v = shx_sum<8>(v); v = shx_sum<16>(v); return shx_sum<32>(v); }

namespace g8 {
constexpr int BM = 256, BK = 64, HALF = 128, HTB = HALF * BK * 2  , STAGE_BYTES = 8 * HTB;

__host__ __device__ __forceinline__ int lds_byte(int r, int c) { const int st = (r >> 4) * 2 + (c >> 5), rr = r & 15, cc = c & 31, ob = rr * 64 + cc * 2; return st * 1024 + (ob ^ (((ob >> 9) & 1) << 5)); }
__host__ __device__ __forceinline__ void stage_rc(int b, int& R, int& C) { const int st = b / 1024, sb = b % 1024, swz = sb ^ (((sb >> 9) & 1) << 5); R = (st >> 1) * 16 + swz / 64; C = (st & 1) * 32 + (swz % 64) / 2; }
__host__ __device__ __forceinline__ int perm32(int rho) { const int n = rho >> 4, i = rho & 15; return 8 * (i >> 2) + 4 * n + (i & 3); }

struct Unit { int pm, pn, e, seg, rows, aux; };

template <bool F8, class Epi, class Sched>
__device__ __forceinline__ void gemm_phase_t(LAS unsigned char* lds, const Sched& S, const Epi& E, int wid) {
    constexpr bool GATHER = Sched::GATHER;
    const int lane = fresh_lane(), tid = wid * 64 + lane, wr = wid >> 2, wc = wid & 3, fr = lane & 15, fq = lane >> 4;
    const int nt = S.nt;
    const unsigned lda = S.lda, ldb = S.ldb;
    int R0, C0;
    { const int sb = lane * 16, swz = sb ^ (((sb >> 9) & 1) << (F8 ? 4 : 5)); R0 = (wid >> 1) * 16 + swz / 64; C0 = (wid & 1) * 32 + (swz % 64) / 2; }
    constexpr int PM = (int)Epi::PERM;
    const int rho0 = PM ? ((R0 & ~31) + perm32(R0 & 31)) : R0;
    const int Rb0 = (PM == 2) ? 16 * (rho0 >> 3) + (rho0 & 7) : rho0;
    const unsigned voffB = (unsigned)Rb0 * ldb + (unsigned)C0 * 2u;
    const unsigned voffA = (unsigned)R0 * lda + (unsigned)C0 * 2u;
    const size_t kstep = (size_t)(BK * 2);
    const size_t hstepB = (size_t)((PM == 2) ? 8 : HALF) * ldb, hstepA = (size_t)HALF * lda, qB = (size_t)((PM == 2) ? 128 : 64) * ldb, qA = (size_t)64 * lda;
    const unsigned ldsw = (unsigned)wid * 1024u;
    const int f8o = (fq >> 1) * 1024 + fr * 64 + (fq & 1) * 32, f8s = (fr >> 3) * 16;
    const int aoff = F8 ? wr * 8192 + f8o + f8s : lds_byte(wr * 64 + fr, fq * 8), boff = F8 ? wc * 4096 + f8o + f8s : lds_byte(wc * 32 + fr, fq * 8);
    const int hi8 = 16 - 2 * f8s;
#define G8_SA(b, h) (((b) * 2 + (h)) * HTB)
#define G8_SB(b, h) ((4 + (b) * 2 + (h)) * HTB)
#define G8_GLDS(gptr, ldsoff) __builtin_amdgcn_global_load_lds((const unsigned*)(gptr), (LAS unsigned*)(lds + (ldsoff)), 16, 0, 0)
#define G8_OPQ(x) ({ unsigned o_ = (x); asm volatile("" : "+v"(o_)); o_; })
#define G8_STAGE_B(bufoff, gbase) do { const unsigned o_ = G8_OPQ(voffB); G8_GLDS((const char*)(gbase) + o_, (bufoff) + ldsw); G8_GLDS((const char*)(gbase) + qB + o_, (bufoff) + ldsw + 8192); } while (0)
#define G8_STAGE_A(bufoff, gbase, h, gv) do { if constexpr (GATHER) { const unsigned o0_ = G8_OPQ((gv)[0]), o1_ = G8_OPQ((gv)[1]); G8_GLDS((const char*)(gbase) + o0_, (bufoff) + ldsw); G8_GLDS((const char*)(gbase) + o1_, (bufoff) + ldsw + 8192); } \
        else { const unsigned o_ = G8_OPQ(voffA); G8_GLDS((const char*)(gbase) + (h) * hstepA + o_, (bufoff) + ldsw); G8_GLDS((const char*)(gbase) + (h) * hstepA + qA + o_, (bufoff) + ldsw + 8192); } } while (0)
#define G8_LDA(dst, b, h) do { _Pragma("unroll") for (int m = 0; m < 4; ++m) _Pragma("unroll") for (int k = 0; k < 2; ++k) dst[m][k] = *(const LAS bf16x8*)(lds + G8_SA(b, h) + aoff + m * 2048 + k * 1024); } while (0)
#define G8_LDB(dst, b, h) do { _Pragma("unroll") for (int n = 0; n < 2; ++n) _Pragma("unroll") for (int k = 0; k < 2; ++k) dst[n][k] = *(const LAS bf16x8*)(lds + G8_SB(b, h) + boff + n * 2048 + k * 1024); } while (0)
#define G8_LD8(dst, off) do { const u32x4 lo_ = *(const LAS u32x4*)(lds + (off)), hi_ = *(const LAS u32x4*)(lds + (off) + hi8); \
        dst = (i32x8){(int)lo_[0], (int)lo_[1], (int)lo_[2], (int)lo_[3], (int)hi_[0], (int)hi_[1], (int)hi_[2], (int)hi_[3]}; } while (0)
#define G8_LDA8(dst, b, h) do { _Pragma("unroll") for (int m = 0; m < 4; ++m) G8_LD8(dst[m], G8_SA(b, h) + aoff + m * 2048); } while (0)
#define G8_LDB8(dst, b, h) do { _Pragma("unroll") for (int n = 0; n < 2; ++n) G8_LD8(dst[n], G8_SB(b, h) + boff + n * 2048); } while (0)
#define G8_MMA8(ai, bj, At, Bt) do { __builtin_amdgcn_s_setprio(1); _Pragma("unroll") for (int m = 0; m < 4; ++m) _Pragma("unroll") for (int n = 0; n < 2; ++n) \
        asm volatile("v_mfma_scale_f32_16x16x128_f8f6f4 %0, %1, %2, %0, %3, %3 op_sel_hi:[0,0,0]" : "+v"(acc[ai][bj][m][n]) : "v"(Bt[n]), "v"(At[m]), "v"(one8)); __builtin_amdgcn_s_setprio(0); } while (0)
#define G8_MMA(ai, bj, At, Bt) do { __builtin_amdgcn_s_setprio(1); _Pragma("unroll") for (int m = 0; m < 4; ++m) _Pragma("unroll") for (int n = 0; n < 2; ++n) _Pragma("unroll") for (int k = 0; k < 2; ++k) \
        acc[ai][bj][m][n] = __builtin_amdgcn_mfma_f32_16x16x32_bf16(Bt[n][k], At[m][k], acc[ai][bj][m][n], 0, 0, 0); __builtin_amdgcn_s_setprio(0); } while (0)
#define G8_WAIT_V(n) asm volatile("s_waitcnt vmcnt(" #n ")" ::: "memory")
#define G8_WAIT_L(n) asm volatile("s_waitcnt lgkmcnt(" #n ")" ::: "memory")
#define G8_BAR __builtin_amdgcn_s_barrier()
#define G8_SCHED __builtin_amdgcn_sched_barrier(0)
    Unit cur, nxt; int ui = 0;
    if (!S.next(0, cur)) return;
    f32x4 acc[2][2][4][2];
#pragma unroll
    for (int a = 0; a < 2; ++a)
#pragma unroll
        for (int b = 0; b < 2; ++b)
#pragma unroll
            for (int m = 0; m < 4; ++m)
#pragma unroll
                for (int n = 0; n < 2; ++n) acc[a][b][m][n] = (f32x4){0.f, 0.f, 0.f, 0.f};
    bf16x8 At[4][2], B0[2][2], B1[2][2]; i32x8 At8[4], B08[2], B18[2]; const int one8 = 0x7f7f7f7f;
    const char* cA = S.a_base(cur); const char* cB = S.b_base(cur);
    {   unsigned vG0[2] = {0u, 0u}, vG1[2] = {0u, 0u};
        if constexpr (GATHER) S.g_off(cur, R0, C0 * 2, vG0, vG1);
    G8_STAGE_B(G8_SB(0, 0), cB); G8_STAGE_B(G8_SB(0, 1), cB + hstepB); G8_STAGE_A(G8_SA(0, 0), cA, 0, vG0); G8_STAGE_A(G8_SA(0, 1), cA, 1, vG1);
    if (wr == 1) G8_BAR;
    G8_WAIT_V(2); G8_BAR;
    G8_STAGE_B(G8_SB(1, 0), cB + kstep); G8_STAGE_A(G8_SA(1, 0), cA + kstep, 0, vG0); G8_STAGE_B(G8_SB(1, 1), cB + hstepB + kstep);
    G8_WAIT_V(6); G8_BAR; }
    for (;;) {
        const bool has_next = S.next(ui + 1, nxt);
        const char* nA = has_next ? S.a_base(nxt) : cA; const char* nB = has_next ? S.b_base(nxt) : cB;
        for (int t = 0; t < nt; t += 2) {
            const bool last = (t == nt - 2);
            const char* a1 = cA + (size_t)(t + 1) * kstep;
            const char* a2 = last ? nA : cA + (size_t)(t + 2) * kstep; const char* b2 = last ? nB : cB + (size_t)(t + 2) * kstep;
            const char* a3 = a2 + kstep; const char* b3 = b2 + kstep;
            unsigned vG0[2] = {0u, 0u}, vG1[2] = {0u, 0u}, x0[2] = {0u, 0u}, x1[2] = {0u, 0u};
            if constexpr (GATHER) { S.g_off(cur, R0, C0 * 2, vG0, vG1); if (last && has_next) S.g_off(nxt, R0, C0 * 2, x0, x1); else { x0[0] = vG0[0]; x0[1] = vG0[1]; x1[0] = vG1[0]; x1[1] = vG1[1]; } }
            if constexpr (!F8) {
            G8_LDB(B0, 0, 0); G8_LDB(B1, 0, 1); G8_SCHED; G8_LDA(At, 0, 0); G8_STAGE_A(G8_SA(1, 1), a1, 1, vG1);
            G8_WAIT_V(8); G8_WAIT_L(0); G8_BAR; G8_MMA(0, 0, At, B0); G8_MMA(0, 1, At, B1); G8_BAR; G8_SCHED;
            G8_LDA(At, 0, 1); G8_STAGE_B(G8_SB(0, 0), b2); G8_STAGE_B(G8_SB(0, 1), b2 + hstepB); G8_STAGE_A(G8_SA(0, 0), a2, 0, x0);
            G8_WAIT_V(8); G8_WAIT_L(0); G8_BAR; G8_MMA(1, 0, At, B0); G8_MMA(1, 1, At, B1); G8_BAR; G8_SCHED;
            G8_LDB(B0, 1, 0); G8_LDB(B1, 1, 1); G8_SCHED; G8_LDA(At, 1, 0); G8_STAGE_A(G8_SA(0, 1), a2, 1, x1);
            G8_WAIT_V(8); G8_WAIT_L(0); G8_BAR; G8_MMA(0, 0, At, B0); G8_MMA(0, 1, At, B1); G8_BAR; G8_SCHED;
            G8_LDA(At, 1, 1); G8_STAGE_B(G8_SB(1, 0), b3); G8_STAGE_B(G8_SB(1, 1), b3 + hstepB); G8_STAGE_A(G8_SA(1, 0), a3, 0, x0);
            G8_WAIT_V(8); G8_WAIT_L(0); G8_BAR; G8_MMA(1, 0, At, B0); G8_MMA(1, 1, At, B1); G8_BAR; G8_SCHED;
            } else {
            G8_LDB8(B08, 0, 0); G8_LDB8(B18, 0, 1); G8_SCHED; G8_LDA8(At8, 0, 0); G8_STAGE_A(G8_SA(1, 1), a1, 1, vG1);
            G8_WAIT_V(8); G8_WAIT_L(0); G8_BAR; G8_MMA8(0, 0, At8, B08); G8_MMA8(0, 1, At8, B18); G8_BAR; G8_SCHED;
            G8_LDA8(At8, 0, 1); G8_STAGE_B(G8_SB(0, 0), b2); G8_STAGE_B(G8_SB(0, 1), b2 + hstepB); G8_STAGE_A(G8_SA(0, 0), a2, 0, x0);
            G8_WAIT_V(8); G8_WAIT_L(0); G8_BAR; G8_MMA8(1, 0, At8, B08); G8_MMA8(1, 1, At8, B18); G8_BAR; G8_SCHED;
            G8_LDB8(B08, 1, 0); G8_LDB8(B18, 1, 1); G8_SCHED; G8_LDA8(At8, 1, 0); G8_STAGE_A(G8_SA(0, 1), a2, 1, x1);
            G8_WAIT_V(8); G8_WAIT_L(0); G8_BAR; G8_MMA8(0, 0, At8, B08); G8_MMA8(0, 1, At8, B18); G8_BAR; G8_SCHED;
            G8_LDA8(At8, 1, 1); G8_STAGE_B(G8_SB(1, 0), b3); G8_STAGE_B(G8_SB(1, 1), b3 + hstepB); G8_STAGE_A(G8_SA(1, 0), a3, 0, x0);
            G8_WAIT_V(8); G8_WAIT_L(0); G8_BAR; G8_MMA8(1, 0, At8, B08); G8_MMA8(1, 1, At8, B18); G8_BAR; G8_SCHED;
            }
        }
        if constexpr (F8) asm volatile("s_nop 15\n\ts_nop 15" ::: "memory");
        if (wr == 0) G8_BAR;
        { const int l2 = fresh_lane(); E(acc, cur, wr, wc, l2 & 15, l2 >> 4); }
        if (!has_next) break;
        if (!E.keep(cur)) {
#pragma unroll
            for (int a = 0; a < 2; ++a)
#pragma unroll
                for (int b = 0; b < 2; ++b)
#pragma unroll
                    for (int m = 0; m < 4; ++m)
#pragma unroll
                        for (int n = 0; n < 2; ++n) acc[a][b][m][n] = (f32x4){0.f, 0.f, 0.f, 0.f};
        }
        cur = nxt; cA = nA; cB = nB; ++ui;
        if (wr == 1) G8_BAR;
    }
    G8_WAIT_V(0);
    G8_BAR;
#undef G8_SA
#undef G8_SB
#undef G8_GLDS
#undef G8_OPQ
#undef G8_STAGE_A
#undef G8_STAGE_B
#undef G8_LDA
#undef G8_LDB
#undef G8_LDA8
#undef G8_LD8
#undef G8_LDB8
#undef G8_MMA8
#undef G8_MMA
#undef G8_WAIT_V
#undef G8_WAIT_L
#undef G8_BAR
#undef G8_SCHED
}
template <class Epi, class Sched> __device__ __forceinline__ void gemm_phase(LAS unsigned char* lds, const Sched& S, const Epi& E, int wid) { gemm_phase_t<false>(lds, S, E, wid); }
template <class Epi, class Sched> __device__ __forceinline__ void gemm_phase_f8(LAS unsigned char* lds, const Sched& S, const Epi& E, int wid) { gemm_phase_t<true>(lds, S, E, wid); }

struct DenseSched {
    static constexpr bool GATHER = false;
    const char* A; const char* Bt; unsigned lda, ldb; int nM, nN, nseg, nt, G, c; unsigned segbytes; int lo, hi;
    __device__ __forceinline__ bool next(int i_, Unit& u) const {
        const int i = i_ + lo; if (i >= hi) return false;
        const int tile = (i / nseg) * G + c; if (tile >= nM * nN) return false;
        const int nig = 8 * nN, gid = tile / nig, fm = gid * 8, gsz = (nM - fm) < 8 ? (nM - fm) : 8;
        u.pm = fm + ((tile % nig) % gsz); u.pn = (tile % nig) / gsz; u.e = 0; u.seg = i % nseg; u.rows = 256; u.aux = 0; return true;
    }
    __device__ __forceinline__ const char* a_base(const Unit& u) const { return A + (size_t)u.pm * 256 * lda + (size_t)u.seg * segbytes; }
    __device__ __forceinline__ const char* b_base(const Unit& u) const { return Bt + (size_t)u.pn * 256 * ldb + (size_t)u.seg * segbytes; }
};
}

constexpr int NWAVES = 8;
constexpr size_t MiB = 1u << 20;
constexpr size_t WS_CTL = 0, CTL_ZERO_BYTES = 64 * 1024;
constexpr size_t WS_WR = 1 * MiB;
constexpr size_t WS_LIST = 1536 * 1024;
constexpr size_t WS_H1 = 8 * MiB;
constexpr size_t WS_WGU = 40 * MiB;
constexpr size_t WS_WD = 300 * MiB;
constexpr size_t WS_ACT = 430 * MiB;
constexpr size_t WS_PRE1 = 430 * MiB;
constexpr size_t WS_Y = 518 * MiB;
constexpr size_t WS_WIN = 518 * MiB;
constexpr size_t WS_WGLU = 534 * MiB;
constexpr size_t WS_WOUT = 538 * MiB;
constexpr size_t WS_XB = 546 * MiB;
constexpr size_t WS_UG = 578 * MiB;
constexpr size_t WS_QH = 594 * MiB;
constexpr size_t WS_KH = 610 * MiB;
constexpr size_t WS_VH = 626 * MiB;
constexpr size_t WS_SW1 = 642 * MiB;
constexpr size_t WS_SWC = 650 * MiB;
constexpr size_t WS_GY = 690 * MiB;
constexpr size_t WS_MG = 706 * MiB;
constexpr size_t WS_OP = 738 * MiB;
constexpr size_t WS_H1F = 370 * MiB;
constexpr size_t WS_TAB = 790 * MiB;
constexpr size_t WS_PART = 792 * MiB;
constexpr size_t WS_END = 806 * MiB;
constexpr int CW_BAR = 4096;
constexpr int CW_QD = 11936;
constexpr int CW_SSMDONE = 12128, CW_Q3 = 12192;
constexpr int CW_C3 = 12544, CW_CA = 12608, CW_Q4 = 12672;
constexpr int CW_QM = 12000, CW_QC = 12064;
constexpr int CW_CNT = 12288;
static_assert((CW_CNT + 128) * 4 <= (int)CTL_ZERO_BYTES, "ctl");

constexpr size_t PART_SS = 0, PART_SA = 32 * 8192, PART_LS = 48 * 8192, PART_LQ = 80 * 8192;
constexpr float YSCALE8 = 32.f, YUNSCALE8 = 1.f / 32.f;
constexpr float WSCALE8 = 32.f, WUNSCALE8 = 1.f / 32.f;
constexpr int RING_BYTES = 131072, MISC_OFF = RING_BYTES, LDS_BYTES = 147456;

#define RLX_AGENT __ATOMIC_RELAXED, __HIP_MEMORY_SCOPE_AGENT
#define LDS_WAIT() asm volatile("s_waitcnt lgkmcnt(0)" ::: "memory")
#define VM_WAIT() asm volatile("s_waitcnt vmcnt(0)" ::: "memory")

#define XB_TMO      128
#define XB_XCNT(j)  (256  + 64 * (j))
#define XB_XSUB(j)  (1280 + 64 * (j))
#define XB_XGEN(j)  (2304 + 64 * (j))
#define XB_TOP      3328
#define XB_TOPGEN   3392
#define XCD_BAR_WORDS 3456
#define XB_SPIN_CAP (1u << 22)
__device__ __forceinline__ unsigned xb_ld(unsigned* p)              { return __hip_atomic_load(p, __ATOMIC_RELAXED, __HIP_MEMORY_SCOPE_AGENT); }
__device__ __forceinline__ unsigned xb_add(unsigned* p, unsigned v) { return __hip_atomic_fetch_add(p, v, __ATOMIC_RELAXED, __HIP_MEMORY_SCOPE_AGENT); }
__device__ __forceinline__ unsigned xb_xcc_id() { return (unsigned)__builtin_amdgcn_s_getreg((3 << 11) | 20) & 0xFu; }
#define XB_SPIN(cond, bar) do { unsigned _sp = 0; while (cond) { __builtin_amdgcn_s_sleep(1); \
    if ((++_sp & 255u) == 0u) { if (xb_ld(&(bar)[XB_TMO])) break; if (_sp > XB_SPIN_CAP) { atomicAdd(&(bar)[XB_TMO], 1u); break; } } } } while (0)
struct XcdBarrier { unsigned* bar; unsigned x; volatile LAS unsigned* st; };
__device__ __forceinline__ XcdBarrier xcd_barrier_post(unsigned* bar, volatile LAS unsigned* st) {
    XcdBarrier b; b.bar = bar; b.x = xb_xcc_id(); b.st = st;
    if (threadIdx.x == 0) (void)xb_add(&bar[XB_XCNT(b.x)], 1u);
    return b;
}
__device__ __forceinline__ void xcd_barrier_complete(unsigned* bar, unsigned x, unsigned& nloc, unsigned& nx) {
    const unsigned G = gridDim.x * gridDim.y * gridDim.z;
    unsigned sum, cnt, mine, sp = 0u;
    for (;;) {
        sum = 0u; cnt = 0u; mine = 0u;
#pragma unroll
        for (unsigned j = 0; j < 16; ++j) { const unsigned c = xb_ld(&bar[XB_XCNT(j)]); sum += c; cnt += (c > 0u) ? 1u : 0u; mine = (j == x) ? c : mine; }
        if (sum == G) break;
        __builtin_amdgcn_s_sleep(1);
        if ((++sp & 255u) == 0u) { if (xb_ld(&bar[XB_TMO])) break; if (sp > XB_SPIN_CAP) { atomicAdd(&bar[XB_TMO], 1u); break; } }
    }
    nloc = mine > 0u ? mine : 1u; nx = cnt > 0u ? cnt : 1u;
}
__device__ __forceinline__ void xcd_barrier(const XcdBarrier& b, int wave) {
    asm volatile("s_waitcnt vmcnt(0)" ::: "memory");
    __syncthreads();
    if (wave == 0 && fresh_lane() == 0) {
        unsigned* bar = b.bar;
        __builtin_amdgcn_s_waitcnt(0);
        unsigned nloc = b.st[0], nx = b.st[1];
        if (nloc == 0u) { xcd_barrier_complete(bar, b.x, nloc, nx); b.st[0] = nloc; b.st[1] = nx; }
        const unsigned old = xb_add(&bar[XB_XSUB(b.x)], 1u);
        const unsigned gen = old / nloc;
        if (old + 1u == (gen + 1u) * nloc) {
            __builtin_amdgcn_fence(__ATOMIC_RELEASE, "agent");
            asm volatile("s_waitcnt vmcnt(0)" ::: "memory");
            const unsigned og = xb_add(&bar[XB_TOP], 1u);
            const unsigned tg = og / nx;
            if (og + 1u == (tg + 1u) * nx) xb_add(&bar[XB_TOPGEN], 1u);
            else XB_SPIN(xb_ld(&bar[XB_TOPGEN]) == tg, bar);
            __builtin_amdgcn_fence(__ATOMIC_ACQUIRE, "agent");
            xb_add(&bar[XB_XGEN(b.x)], 1u);
            asm volatile("s_waitcnt vmcnt(0)" ::: "memory");
        } else {
            XB_SPIN(xb_ld(&bar[XB_XGEN(b.x)]) == gen, bar);
            __builtin_amdgcn_fence(__ATOMIC_ACQUIRE, "agent");
            asm volatile("s_waitcnt vmcnt(0)" ::: "memory");
        }
    }
    __syncthreads();
}

struct Args { const float* in[26]; float* out; unsigned char* ws; int ph_lo, ph_hi, use_bar, pad; };
struct Frame {
    LAS unsigned char* lds; volatile LAS unsigned* MISC; unsigned* ctl; unsigned char* ws;
    int tid, lane, wave, vcu, G;
};

__device__ __forceinline__ void transpose_item(const float* W, int N, bf16_t* WT, int ldt, int k0, int n0, int orow0, const float* kscale, LAS unsigned char* tile, int lane) {
    const int lr = lane >> 4, lc = lane & 15;
    f32x4 v[16];
#pragma unroll
    for (int i = 0; i < 16; ++i) v[i] = __builtin_nontemporal_load((const GAS f32x4*)(W + (size_t)(k0 + 4 * i + lr) * N + n0 + 4 * lc));
#pragma unroll
    for (int i = 0; i < 16; ++i) { f32x4 x = v[i]; if (kscale) x = x * kscale[k0 + 4 * i + lr];
        u32x2 o; o.x = pk2(x[0], x[1]); o.y = pk2(x[2], x[3]); *(LAS u32x2*)(tile + (4 * i + lr) * 144 + lc * 8) = o; }
    asm volatile("s_waitcnt lgkmcnt(0)" ::: "memory");
    const int G = lane >> 4, q = (lane & 15) >> 2, pp = lane & 3;
#pragma unroll
    for (int t = 0; t < 8; ++t) { const int nb = t & 3, c = 4 * (t >> 2) + G;
        LAS unsigned char* a = tile + (8 * c + q) * 144 + (16 * nb + 4 * pp) * 2;
        const s16x4 t0 = __builtin_bit_cast(s16x4, __builtin_amdgcn_ds_read_tr16_b64_v4i16((LAS s16x4*)a));
        const s16x4 t1 = __builtin_bit_cast(s16x4, __builtin_amdgcn_ds_read_tr16_b64_v4i16((LAS s16x4*)(a + 4 * 144)));
        const bf16x8 o = (bf16x8){t0[0], t0[1], t0[2], t0[3], t1[0], t1[1], t1[2], t1[3]};
        *(GAS bf16x8*)(WT + (size_t)(orow0 + 16 * nb + (lane & 15)) * ldt + k0 + 8 * c) = o; }
    asm volatile("s_waitcnt lgkmcnt(0)" ::: "memory");
}
__device__ __forceinline__ int glu_row(int j) { return (j >> 7) * 256 + (j & 127); }
struct F8Item { const float* W; unsigned char* WT8; int N, ldt, k0, n0, orow0; const float* ks; };
__device__ __forceinline__ void f8_item_load(const F8Item& it, f32x4 (&v)[16], int lane) {
    const int lr = lane >> 4, lc = lane & 15;
#pragma unroll
    for (int i = 0; i < 16; ++i) v[i] = __builtin_nontemporal_load((const GAS f32x4*)(it.W + (size_t)(it.k0 + 4 * i + lr) * it.N + it.n0 + 4 * lc));
}
__device__ __forceinline__ void f8_item_process(const F8Item& it, const f32x4 (&v)[16], float wscale, LAS unsigned char* tile, int lane) {
    const int lr = lane >> 4, lc = lane & 15;
#pragma unroll
    for (int i = 0; i < 16; ++i) { const f32x4 x = it.ks ? v[i] * it.ks[it.k0 + 4 * i + lr] : v[i]; u32x2 o; o.x = pk2(x[0], x[1]); o.y = pk2(x[2], x[3]); *(LAS u32x2*)(tile + (4 * i + lr) * 144 + lc * 8) = o; }
    asm volatile("s_waitcnt lgkmcnt(0)" ::: "memory");
    const int G = lane >> 4, q = (lane & 15) >> 2, pp = lane & 3;
#pragma unroll
    for (int t = 0; t < 4; ++t) {
        LAS unsigned char* a = tile + (16 * G + q) * 144 + (16 * t + 4 * pp) * 2; u32x4 o;
#pragma unroll
        for (int j = 0; j < 4; ++j) { const u32x2 tr = __builtin_bit_cast(u32x2, __builtin_amdgcn_ds_read_tr16_b64_v4i16((LAS s16x4*)(a + 4 * j * 144)));
            o[j] = pk4_fp8_bf16(tr.x, tr.y, 1.f / wscale); }
        *(GAS u32x4*)(it.WT8 + (size_t)(it.orow0 + 16 * t + (lane & 15)) * it.ldt + it.k0 + 16 * G) = o; }
    asm volatile("s_waitcnt lgkmcnt(0)" ::: "memory");
}
__device__ __forceinline__ F8Item f8_item_of(const Args& args, unsigned char* ws, int set, int it) {
    constexpr int I_G = 32 * 8; F8Item d; d.ks = nullptr;
    if (set == 0) { const int e = it / (2 * I_G); int r = it - e * 2 * I_G; const int up = r >= I_G ? 1 : 0; r -= up * I_G; const int kb = r / 8, nb = r % 8;
        d.W = e < NEXP ? args.in[18 + up] + (size_t)e * DM * DEXP : args.in[21 + up]; d.WT8 = ws + WS_WGU + (size_t)e * 1024 * DM; d.N = DEXP; d.ldt = DM; d.k0 = kb * 64; d.n0 = nb * 64; d.orow0 = glu_row(nb * 64) + 128 * up; }
    else { const int e = it / I_G; const int r = it - e * I_G; const int kb = r / 32, nb = r % 32;
        d.W = e < NEXP ? args.in[20] + (size_t)e * DEXP * DM : args.in[23]; d.WT8 = ws + WS_WD + (size_t)e * DM * DEXP; d.N = DM; d.ldt = DEXP; d.k0 = kb * 64; d.n0 = nb * 64; d.orow0 = nb * 64; }
    return d;
}
__device__ __forceinline__ void f8_convert_items(const Args& args, unsigned char* ws, LAS unsigned char* lds, int set, int it0, int wave, int lane) {
    LAS unsigned char* tile = lds + wave * 9216;
    f32x4 va[16], vb[16], vc[16];
    F8Item da = f8_item_of(args, ws, set, it0), db = f8_item_of(args, ws, set, it0 + 1), dc = f8_item_of(args, ws, set, it0 + 2);
    f8_item_load(da, va, lane); f8_item_load(db, vb, lane); f8_item_load(dc, vc, lane);
    f8_item_process(da, va, WSCALE8, tile, lane); da = f8_item_of(args, ws, set, it0 + 3); f8_item_load(da, va, lane);
    f8_item_process(db, vb, WSCALE8, tile, lane); db = f8_item_of(args, ws, set, it0 + 4); f8_item_load(db, vb, lane);
    f8_item_process(dc, vc, WSCALE8, tile, lane); dc = f8_item_of(args, ws, set, it0 + 5); f8_item_load(dc, vc, lane);
    f8_item_process(da, va, WSCALE8, tile, lane); da = f8_item_of(args, ws, set, it0 + 6); f8_item_load(da, va, lane);
    f8_item_process(db, vb, WSCALE8, tile, lane); db = f8_item_of(args, ws, set, it0 + 7); f8_item_load(db, vb, lane);
    f8_item_process(dc, vc, WSCALE8, tile, lane);
    f8_item_process(da, va, WSCALE8, tile, lane);
    f8_item_process(db, vb, WSCALE8, tile, lane);
}
__device__ __forceinline__ void f8_convert_chunk(const Args& args, unsigned char* ws, LAS unsigned char* lds, int set, int chunk, int wave, int lane) { f8_convert_items(args, ws, lds, set, chunk * 64 + wave * 8, wave, lane); }
__device__ __forceinline__ void f8_convert_one(const Args& args, unsigned char* ws, LAS unsigned char* lds, int set, int it, int wave, int lane) {
    LAS unsigned char* tile = lds + wave * 9216; f32x4 v[16]; const F8Item d = f8_item_of(args, ws, set, it); f8_item_load(d, v, lane); f8_item_process(d, v, WSCALE8, tile, lane); }
constexpr int NCONV_GU = (65 * 512) / 64, NCONV_D = (65 * 256) / 64;
constexpr int NSUB_D = NCONV_D * 8;

struct EpiIn {
    static constexpr bool PERM = true;
    bf16_t* ug;
    __device__ __forceinline__ bool keep(const g8::Unit&) const { return false; }
    __device__ __forceinline__ void operator()(f32x4 (&acc)[2][2][4][2], const g8::Unit& u, int wr, int wc, int fr, int fq) const {
        asm volatile("" : "+v"(fr), "+v"(fq));
        const int region = u.pn >> 2; const float sc = (region == 1) ? C2Q : 1.f;
        bf16_t* base = ug + (size_t)region * (16 * MiB / 2);
#pragma unroll
        for (int ai = 0; ai < 2; ++ai)
#pragma unroll
            for (int m = 0; m < 4; ++m) {
                const int r = u.pm * 256 + ai * 128 + wr * 64 + m * 16 + fr; const int b = r >> 11, t = r & 2047;
#pragma unroll
                for (int bj = 0; bj < 2; ++bj) {
                    const int c = (u.pn & 3) * 256 + bj * 128 + wc * 32 + 8 * fq;
                    const f32x4 v0 = acc[ai][bj][m][0] * sc, v1 = acc[ai][bj][m][1] * sc;
                    u32x4 w; w.x = pk2(v0[0], v0[1]); w.y = pk2(v0[2], v0[3]); w.z = pk2(v1[0], v1[1]); w.w = pk2(v1[2], v1[3]);
                    size_t off;
                    if (region == 0) off = ((size_t)(b * 64 + (c >> 4)) * 2048 + t) * 16 + (c & 15);
                    else off = ((size_t)(b * 16 + (c >> 6)) * 2048 + t) * 64 + (c & 63);
                    *(GAS u32x4*)(base + off) = w;
                }
            }
    }
};

struct EpiGlu {
    static constexpr bool PERM = true;
    bf16_t* mg; float* ssq;
    __device__ __forceinline__ bool keep(const g8::Unit&) const { return false; }
    __device__ __forceinline__ void operator()(f32x4 (&acc)[2][2][4][2], const g8::Unit& u, int wr, int wc, int fr, int fq) const {
        asm volatile("" : "+v"(fr), "+v"(fq));
        const int col = u.pn * 128 + wc * 32 + 8 * fq;
#pragma unroll
        for (int ai = 0; ai < 2; ++ai)
#pragma unroll
            for (int m = 0; m < 4; ++m) {
                const int r = u.pm * 256 + ai * 128 + wr * 64 + m * 16 + fr;
                float y[8]; float s = 0.f;
#pragma unroll
                for (int n = 0; n < 2; ++n)
#pragma unroll
                    for (int e = 0; e < 4; ++e) { const float v = acc[ai][0][m][n][e] * sigmoid_f(acc[ai][1][m][n][e]); y[4 * n + e] = v; s += v * v; }
                u32x2 w; w.x = pk4_fp8(y[0], y[1], y[2], y[3]); w.y = pk4_fp8(y[4], y[5], y[6], y[7]);
                __hip_atomic_store((unsigned long long*)((unsigned char*)mg + (size_t)r * DM + col), ((unsigned long long)w.y << 32) | w.x, __ATOMIC_RELAXED, __HIP_MEMORY_SCOPE_AGENT);
                s = shx_sum<16>(s); s = shx_sum<32>(s);
                if (fq == 0) __hip_atomic_store((unsigned*)(ssq + (size_t)(u.pn * 4 + wc) * NTOK + r), __builtin_bit_cast(unsigned, s), __ATOMIC_RELAXED, __HIP_MEMORY_SCOPE_AGENT);
            }
    }
};
struct EpiOut {
    static constexpr bool PERM = true;
    const float* x; bf16_t* pre1; const float* part; float* part_w; LAS f32x2* rtab; LAS int* rtab_pm;
    __device__ __forceinline__ bool keep(const g8::Unit& u) const { return u.seg == 0; }
    __device__ __forceinline__ void operator()(f32x4 (&acc)[2][2][4][2], const g8::Unit& u, int wr, int wc, int fr, int fq) const {
        asm volatile("" : "+v"(fr), "+v"(fq));
        if (__builtin_amdgcn_readfirstlane(*rtab_pm) != u.pm) {
            __syncthreads();
            const int t = (wr * 4 + wc) * 64 + fq * 16 + fr;
            if (t < 256) { const int r = u.pm * 256 + t; float ss = 0.f, sa = 0.f;
#pragma unroll 8
                for (int i = 0; i < 32; ++i) ss += part[PART_SS + (size_t)i * NTOK + r];
#pragma unroll 8
                for (int i = 0; i < 16; ++i) sa += part[PART_SA + (size_t)i * NTOK + r];
                rtab[t] = (f32x2){rsqrtf(ss * (1.f / 1024.f) + EPS), rsqrtf(sa * (1.f / 1024.f) + EPS)}; }
            if (t == 0) *rtab_pm = u.pm;
            __syncthreads();
        }
        if (u.seg == 0) {
#pragma unroll
            for (int ai = 0; ai < 2; ++ai)
#pragma unroll
                for (int m = 0; m < 4; ++m) { const f32x2 rr = rtab[ai * 128 + wr * 64 + m * 16 + fr]; const float f = rr.x / rr.y;
#pragma unroll
                    for (int bj = 0; bj < 2; ++bj)
#pragma unroll
                        for (int n = 0; n < 2; ++n) acc[ai][bj][m][n] *= f; }
        } else {
#pragma unroll
            for (int ai = 0; ai < 2; ++ai) { f32x4 xv[4][2][2];
#pragma unroll
                for (int m = 0; m < 4; ++m)
#pragma unroll
                    for (int bj = 0; bj < 2; ++bj) { const size_t off = (size_t)(u.pm * 256 + ai * 128 + wr * 64 + m * 16 + fr) * DM + u.pn * 256 + bj * 128 + wc * 32 + 8 * fq;
                        xv[m][bj][0] = *(const GAS f32x4*)(x + off); xv[m][bj][1] = *(const GAS f32x4*)(x + off + 4); }
                asm volatile("" ::: "memory");
#pragma unroll
                for (int m = 0; m < 4; ++m) { const int rl = ai * 128 + wr * 64 + m * 16 + fr, r = u.pm * 256 + rl; const float ra = rtab[rl].y; float su = 0.f, sq = 0.f;
#pragma unroll
                    for (int bj = 0; bj < 2; ++bj) { const size_t off = (size_t)r * DM + u.pn * 256 + bj * 128 + wc * 32 + 8 * fq;
                        const f32x4 o0 = xv[m][bj][0] * ALPHA + acc[ai][bj][m][0] * (ra * WUNSCALE8), o1 = xv[m][bj][1] * ALPHA + acc[ai][bj][m][1] * (ra * WUNSCALE8);
                        u32x4 w; w.x = pk2(o0[0], o0[1]); w.y = pk2(o0[2], o0[3]); w.z = pk2(o1[0], o1[1]); w.w = pk2(o1[2], o1[3]);
                        *(GAS u32x4*)(pre1 + off) = w;
                        su += (o0[0] + o0[1]) + (o0[2] + o0[3]) + (o1[0] + o1[1]) + (o1[2] + o1[3]);
                        sq += (o0[0] * o0[0] + o0[1] * o0[1]) + (o0[2] * o0[2] + o0[3] * o0[3]) + (o1[0] * o1[0] + o1[1] * o1[1]) + (o1[2] * o1[2] + o1[3] * o1[3]); }
                    su = shx_sum<16>(su); su = shx_sum<32>(su); sq = shx_sum<16>(sq); sq = shx_sum<32>(sq);
                    if (fq == 0) { part_w[PART_LS + (size_t)(u.pn * 4 + wc) * NTOK + r] = su; part_w[PART_LQ + (size_t)(u.pn * 4 + wc) * NTOK + r] = sq; } }
                asm volatile("" ::: "memory");
            }
        }
    }
};

__device__ __forceinline__ void ssm_prep_item(const Args& args, unsigned char* ws, LAS unsigned char* lds, int g, int qtr, int tid) {
    LAS f32x2* PW = (LAS f32x2*)lds;
    LAS f32x2* BB = (LAS f32x2*)(lds + 16896);
    LAS f32x2* CC = (LAS f32x2*)(lds + 25088);
    LAS float* KM = (LAS float*)(lds + 33280);
    LAS float* DD = (LAS float*)(lds + 66048);
    if (tid < 64) {
        const int p = tid; const float are = fminf(args.in[3][g * 64 + p], -1e-4f), aim = args.in[4][g * 64 + p], dt = expf(args.in[2][g * 64 + p]);
        const float mag = expf(are * dt), abr = mag * cosf(aim * dt), abi = mag * sinf(aim * dt);
        float pr = 1.f, pi = 0.f;
        for (int j = 0; j <= 32; ++j) { PW[j * 64 + p] = (f32x2){pr, pi}; const float nr = pr * abr - pi * abi, ni = pr * abi + pi * abr; pr = nr; pi = ni; }
        const float nr = abr - 1.f, ni = abi, den = are * are + aim * aim; const float cr = (nr * are + ni * aim) / den, ci = (ni * are - nr * aim) / den;
        for (int c = 0; c < 16; ++c) { const float br = args.in[5][(g * 64 + p) * 16 + c], bi = args.in[6][(g * 64 + p) * 16 + c]; BB[p * 16 + c] = (f32x2){cr * br - ci * bi, cr * bi + ci * br}; }
    }
    for (int i = tid; i < 1024; i += 512) { const int c = i >> 6, p = i & 63; CC[p * 16 + c] = (f32x2){args.in[7][(g * 16 + c) * 64 + p], args.in[8][(g * 16 + c) * 64 + p]}; }
    if (tid < 16) DD[tid] = args.in[9][g * 16 + tid];
    __syncthreads();
    if (qtr == 0) {
        const int lane = tid & 63, wv = tid >> 6, cc_ = lane & 15, kq = lane >> 4; f32x4 kacc[4];
#pragma unroll
        for (int jj = 0; jj < 4; ++jj) kacc[jj] = (f32x4){0.f, 0.f, 0.f, 0.f};
#pragma unroll 4
        for (int t = 0; t < 16; ++t) { const int p = 4 * t + kq; const float a = CC[p * 16 + cc_].x; const f32x2 bb = BB[p * 16 + cc_];
#pragma unroll
            for (int jj = 0; jj < 4; ++jj) { const f32x2 pw = PW[(4 * wv + jj) * 64 + p]; kacc[jj] = __builtin_amdgcn_mfma_f32_16x16x4f32(a, pw.x * bb.x - pw.y * bb.y, kacc[jj], 0, 0, 0); } }
#pragma unroll 4
        for (int t = 0; t < 16; ++t) { const int p = 4 * t + kq; const float a = -CC[p * 16 + cc_].y; const f32x2 bb = BB[p * 16 + cc_];
#pragma unroll
            for (int jj = 0; jj < 4; ++jj) { const f32x2 pw = PW[(4 * wv + jj) * 64 + p]; kacc[jj] = __builtin_amdgcn_mfma_f32_16x16x4f32(a, pw.x * bb.y + pw.y * bb.x, kacc[jj], 0, 0, 0); } }
#pragma unroll
        for (int jj = 0; jj < 4; ++jj)
#pragma unroll
            for (int r = 0; r < 4; ++r) KM[(4 * wv + jj) * 256 + (4 * kq + r) * 16 + cc_] = kacc[jj][r];
    }
    __syncthreads();
    bf16_t* W1t = (bf16_t*)(ws + WS_SW1) + (size_t)g * 128 * 512;
    for (int i = tid; i < 32 * 64; i += 512) { const int n = 32 * qtr + (i >> 6), k0 = (i & 63) * 8, p = n & 63, im = n >> 6, s1 = k0 >> 4, c0 = k0 & 15;
        const f32x2 pw = PW[(31 - s1) * 64 + p]; float v[8];
#pragma unroll
        for (int e = 0; e < 8; ++e) { const f32x2 bb = BB[p * 16 + c0 + e]; v[e] = im ? pw.x * bb.y + pw.y * bb.x : pw.x * bb.x - pw.y * bb.y; }
        u32x4 o; o.x = pk2(v[0], v[1]); o.y = pk2(v[2], v[3]); o.z = pk2(v[4], v[5]); o.w = pk2(v[6], v[7]);
        *(GAS u32x4*)(W1t + (size_t)n * 512 + k0) = o; }
    bf16_t* W3t = (bf16_t*)(ws + WS_SWC) + (size_t)g * 512 * 128;
    for (int i = tid; i < 128 * 16; i += 512) { const int n2 = 128 * qtr + (i >> 4), k0 = (i & 15) * 8, s = n2 >> 4, c = n2 & 15, im = k0 >> 6, p0 = k0 & 63; float v[8];
#pragma unroll
        for (int e = 0; e < 8; ++e) { const f32x2 cc = CC[(p0 + e) * 16 + c], pw = PW[(s + 1) * 64 + p0 + e]; v[e] = im ? -(cc.x * pw.y + cc.y * pw.x) : cc.x * pw.x - cc.y * pw.y; }
        u32x4 o; o.x = pk2(v[0], v[1]); o.y = pk2(v[2], v[3]); o.z = pk2(v[4], v[5]); o.w = pk2(v[6], v[7]);
        *(GAS u32x4*)(W3t + (size_t)n2 * 128 + k0) = o; }
    if (qtr == 0) { bf16_t* KT = (bf16_t*)(ws + WS_TAB + 65536) + (size_t)g * 33 * 256;
        for (int i = tid; i < 33 * 32; i += 512) { const int L1 = i >> 5, c = (i & 31) >> 1, c0 = (i & 1) * 8; float v[8];
#pragma unroll
            for (int e = 0; e < 8; ++e) v[e] = L1 == 0 ? 0.f : KM[(L1 - 1) * 256 + c * 16 + c0 + e] + ((L1 == 1 && c0 + e == c) ? DD[c] : 0.f);
            u32x4 o; o.x = pk2(v[0], v[1]); o.y = pk2(v[2], v[3]); o.z = pk2(v[4], v[5]); o.w = pk2(v[6], v[7]);
            *(GAS u32x4*)(KT + (size_t)i * 8) = o; } }
    if (qtr == 0 && tid < 64) ((f32x2*)(ws + WS_TAB))[g * 64 + tid] = PW[32 * 64 + tid];
    __syncthreads();
}

__device__ __forceinline__ void ssm_unit(unsigned char* ws, LAS unsigned char* lds, int b, int g, int tid, int wave, int lane) {
    asm volatile("" : "+v"(lane), "+v"(tid));
    const int fr = lane & 15, fq = lane >> 4;
    LAS unsigned char* UL = lds;
    LAS float* SM = (LAS float*)(lds + 66560);
    LAS unsigned char* HM = lds + 99328;
    const bf16_t* ug = (const bf16_t*)(ws + WS_UG) + (size_t)(b * 64 + g) * 2048 * 16;
#pragma unroll
    for (int j = 0; j < 8; ++j) { const int i = tid + 512 * j, token = i >> 1, half = i & 1; const u32x4 v = *(const GAS u32x4*)(ug + (size_t)i * 8);
        *(LAS u32x4*)(UL + (token >> 5) * 1040 + (token & 31) * 32 + half * 16) = v; }
    __syncthreads();
    {
        const bf16_t* w1 = (const bf16_t*)(ws + WS_SW1) + ((size_t)g * 128 + 16 * wave + fr) * 512 + 8 * fq;
        f32x4 acc[4];
#pragma unroll
        for (int m = 0; m < 4; ++m) acc[m] = (f32x4){0.f, 0.f, 0.f, 0.f};
#pragma unroll 4
        for (int ks = 0; ks < 16; ++ks) { const bf16x8 a = *(const GAS bf16x8*)(w1 + 32 * ks);
#pragma unroll
            for (int m = 0; m < 4; ++m) { const bf16x8 bb = *(const LAS bf16x8*)(UL + (16 * m + fr) * 1040 + (32 * ks + 8 * fq) * 2); acc[m] = __builtin_amdgcn_mfma_f32_16x16x32_bf16(a, bb, acc[m], 0, 0, 0); } }
#pragma unroll
        for (int m = 0; m < 4; ++m) *(LAS f32x4*)(SM + (16 * m + fr) * 128 + 16 * wave + 4 * fq) = acc[m];
    }
    __syncthreads();
    if (wave == 0) {
        const int p = lane; const f32x2 at = ((const f32x2*)(ws + WS_TAB))[g * 64 + p]; float hr = 0.f, hi = 0.f;
        for (int c0 = 0; c0 < 64; c0 += 16) { float sr[16], si[16];
#pragma unroll
            for (int j = 0; j < 16; ++j) { sr[j] = SM[(c0 + j) * 128 + p]; si[j] = SM[(c0 + j) * 128 + 64 + p]; }
            asm volatile("s_waitcnt lgkmcnt(0)" ::: "memory");
#pragma unroll
            for (int j = 0; j < 16; ++j) { LAS bf16_t* hrow = (LAS bf16_t*)(HM + (c0 + j) * 272); hrow[p] = (bf16_t)f2bf(hr); hrow[64 + p] = (bf16_t)f2bf(hi);
                const float nr = at.x * hr - at.y * hi + sr[j], ni = at.x * hi + at.y * hr + si[j]; hr = nr; hi = ni; } }
    }
    __syncthreads();
    {
#define SSM_T(tt) ((tt) == 0 ? wave : (tt) == 1 ? 15 - wave : (tt) == 2 ? 16 + wave : 31 - wave)
        const bf16_t* w3 = (const bf16_t*)(ws + WS_SWC) + (size_t)g * 512 * 128 + 8 * fq;
        const bf16_t* kt = (const bf16_t*)(ws + WS_TAB + 65536) + (size_t)g * 33 * 256 + (1 - (fq >> 1)) * 256 + fr * 16 + 8 * (fq & 1);
        f32x4 acc[4][4];
#pragma unroll
        for (int tt = 0; tt < 4; ++tt)
#pragma unroll
            for (int m = 0; m < 4; ++m) acc[tt][m] = (f32x4){0.f, 0.f, 0.f, 0.f};
        const int ksmax = (31 - wave) >> 1;
        bf16x8 an[4];
#pragma unroll
        for (int tt = 0; tt < 4; ++tt) an[tt] = *(const GAS bf16x8*)(kt + SSM_T(tt) * 256);
        for (int ks = 0; ks <= ksmax; ++ks) { bf16x8 bb[4], ac[4];
#pragma unroll
            for (int tt = 0; tt < 4; ++tt) ac[tt] = an[tt];
#pragma unroll
            for (int tt = 0; tt < 4; ++tt) { const int t = SSM_T(tt); if (ks + 1 <= (t >> 1)) an[tt] = *(const GAS bf16x8*)(kt + (t - 2 * (ks + 1)) * 256); }
#pragma unroll
            for (int m = 0; m < 4; ++m) bb[m] = *(const LAS bf16x8*)(UL + (16 * m + fr) * 1040 + (32 * ks + 8 * fq) * 2);
#pragma unroll
            for (int tt = 0; tt < 4; ++tt) { const int t = SSM_T(tt);
                if (ks <= (t >> 1)) {
#pragma unroll
                    for (int m = 0; m < 4; ++m) acc[tt][m] = __builtin_amdgcn_mfma_f32_16x16x32_bf16(ac[tt], bb[m], acc[tt][m], 0, 0, 0); } } }
#pragma unroll
        for (int j = 0; j < 4; ++j) { bf16x8 bb[4];
#pragma unroll
            for (int m = 0; m < 4; ++m) bb[m] = *(const LAS bf16x8*)(HM + (16 * m + fr) * 272 + (32 * j + 8 * fq) * 2);
#pragma unroll
            for (int tt = 0; tt < 4; ++tt) { const int t = SSM_T(tt); const bf16x8 a = *(const GAS bf16x8*)(w3 + (size_t)(16 * t + fr) * 128 + 32 * j);
#pragma unroll
                for (int m = 0; m < 4; ++m) acc[tt][m] = __builtin_amdgcn_mfma_f32_16x16x32_bf16(a, bb[m], acc[tt][m], 0, 0, 0); } }
        bf16_t* GY = (bf16_t*)(ws + WS_GY);
#pragma unroll
        for (int tt = 0; tt < 4; ++tt) { const int t = SSM_T(tt);
#pragma unroll
            for (int m = 0; m < 4; ++m) { const int tok = b * 2048 + (16 * m + fr) * 32 + t; const f32x4 v = acc[tt][m];
                u32x2 o; o.x = pk2(gelu_tanh_f(v[0]), gelu_tanh_f(v[1])); o.y = pk2(gelu_tanh_f(v[2]), gelu_tanh_f(v[3]));
                __hip_atomic_store((unsigned long long*)(GY + (size_t)tok * DSSM + 16 * g + 4 * fq), ((unsigned long long)o.y << 32) | o.x, __ATOMIC_RELAXED, __HIP_MEMORY_SCOPE_AGENT); } }
#undef SSM_T
    }
    __syncthreads();
}

__device__ __forceinline__ int crow(int r, int hi) { return (r & 3) + 8 * (r >> 2) + 4 * hi; }
__device__ __forceinline__ void attn_qt(int it, int wave, int sb, int& pat, int& r, int& dil, int& lq0, int& n) {
    const int qi = wave + 8 * it, idx = qi & 15; pat = qi >> 4;
    if (pat == 0) { dil = 1; r = 0; lq0 = 512 * sb + 32 * idx; } else if (pat == 1) { dil = 4; r = idx & 3; lq0 = 128 * sb + 32 * (idx >> 2); } else { dil = 16; r = idx; lq0 = 32 * sb; }
    const int kt0 = lq0 >= 128 ? lq0 - 128 : 0; n = ((lq0 - kt0) >> 5) + 1;
}
__device__ __forceinline__ void attn_unit(unsigned char* ws, unsigned* ctl, LAS unsigned char* lds, int bh, int sb, int tid, int wave, int lane) {
    asm volatile("" : "+v"(lane), "+v"(tid));
    const int b = bh >> 4, h = bh & 15, r32 = lane & 31, hi = lane >> 5;
    const bf16_t* Qh = (const bf16_t*)(ws + WS_QH) + (size_t)bh * 2048 * 64;
    const bf16_t* Kh = (const bf16_t*)(ws + WS_KH) + (size_t)bh * 2048 * 64;
    const bf16_t* Vh = (const bf16_t*)(ws + WS_VH) + (size_t)bh * 2048 * 64;
    LAS unsigned char* vbuf = lds + wave * 12288;
    LAS float* scr = (LAS float*)(lds + 98304 + wave * 256);
    bf16_t* OP = (bf16_t*)(ws + WS_OP); LAS float* lsel = (LAS float*)(lds + 100352);
    const float slope2 = exp2f(-0.5f * (float)(h + 1)) * LOG2E;
    const int trq = (lane & 15) >> 2, trp = lane & 3, trblk = (lane >> 4) & 1;
    const int troff = (4 * hi + trq) * 192 + (16 * trblk + 4 * trp) * 2;
    const int rq = r32 - 4 * hi, self_hi = (r32 >> 2) & 1;
    int lit = 0, lj = 0, lpat, lr, ldil, llq0, ln; attn_qt(0, wave, sb, lpat, lr, ldil, llq0, ln); (void)lpat;
    int cit = 0, cj = 0, pat, r, dil, lq0, n; attn_qt(0, wave, sb, pat, r, dil, lq0, n);
    bf16x8 kA[4], kB[4], kC[4]; u32x4 vA[4], vB[4], vC[4]; bf16x8 qf[4];
    f32x16 o0, o1; float ls = 0.f, ref = 0.f; int vpar = 0;
#define AT_LDQ(dst, r_, dil_, lq0_) do { const int tq_ = (r_) + (dil_) * ((lq0_) + r32); _Pragma("unroll") for (int s = 0; s < 4; ++s) dst[s] = *(const GAS bf16x8*)(Qh + (size_t)tq_ * 64 + 16 * s + 8 * hi); } while (0)
#define AT_LOADJOB(KS, VS) do { if (lit < 6) { const int lk0_ = llq0 - 32 * lj; const int tk_ = lr + ldil * (lk0_ + r32); \
        _Pragma("unroll") for (int s = 0; s < 4; ++s) KS[s] = *(const GAS bf16x8*)(Kh + (size_t)tk_ * 64 + 16 * s + 8 * hi); \
        _Pragma("unroll") for (int j_ = 0; j_ < 4; ++j_) { const int ix_ = lane + 64 * j_; const int tkv_ = lr + ldil * (lk0_ + (ix_ >> 3)); VS[j_] = *(const GAS u32x4*)(Vh + (size_t)tkv_ * 64 + (ix_ & 7) * 8); } \
        if (++lj == ln) { lj = 0; if (++lit < 6) attn_qt(lit, wave, sb, lpat, lr, ldil, llq0, ln); } } } while (0)
#define AT_COMPJOB(KS, VS) do { \
        if (cj == 0) { _Pragma("unroll") for (int e = 0; e < 16; ++e) { o0[e] = 0.f; o1[e] = 0.f; } ls = 0.f; } \
        LAS unsigned char* vb_ = vbuf + vpar * 6144; vpar ^= 1; \
        _Pragma("unroll") for (int j_ = 0; j_ < 4; ++j_) { const int ix_ = lane + 64 * j_; *(LAS u32x4*)(vb_ + (ix_ >> 3) * 192 + (ix_ & 7) * 16) = VS[j_]; } \
        f32x16 a_; _Pragma("unroll") for (int e = 0; e < 16; ++e) a_[e] = 0.f; \
        _Pragma("unroll") for (int s = 0; s < 4; ++s) a_ = __builtin_amdgcn_mfma_f32_32x32x16_bf16(KS[s], qf[s], a_, 0, 0, 0); \
        if (cj == n - 1 && cit + 1 < 6) { int p2_, r2_, d2_, l2_, n2_; attn_qt(cit + 1, wave, sb, p2_, r2_, d2_, l2_, n2_); (void)p2_; (void)n2_; AT_LDQ(qf, r2_, d2_, l2_); }     \
        const float sl_ = slope2 * (float)dil; const int dlt_ = 32 * cj; \
        if (cj == 0) { float mine_ = 0.f; _Pragma("unroll") for (int e = 0; e < 16; ++e) { const int ce_ = (e & 3) + 8 * (e >> 2); mine_ = (ce_ == rq) ? a_[e] : mine_; } \
            const unsigned u_ = __builtin_bit_cast(unsigned, mine_); auto rr_ = __builtin_amdgcn_permlane32_swap(u_, u_, false, false); \
            ref = self_hi ? __builtin_bit_cast(float, (unsigned)rr_[1]) : __builtin_bit_cast(float, (unsigned)rr_[0]); } \
        const float b0_ = -sl_ * (float)(dlt_ + rq) - ref; float p_[16]; \
        if (dlt_ == 0) { _Pragma("unroll") for (int e = 0; e < 16; ++e) { const int ce_ = (e & 3) + 8 * (e >> 2); p_[e] = (ce_ <= rq) ? __builtin_amdgcn_exp2f(fminf(fmaf(sl_, (float)ce_, a_[e] + b0_), 100.f)) : 0.f; } } \
        else if (dlt_ == 128) { _Pragma("unroll") for (int e = 0; e < 16; ++e) { const int ce_ = (e & 3) + 8 * (e >> 2); p_[e] = (ce_ >= rq) ? __builtin_amdgcn_exp2f(fminf(fmaf(sl_, (float)ce_, a_[e] + b0_), 100.f)) : 0.f; } } \
        else { _Pragma("unroll") for (int e = 0; e < 16; ++e) { const int ce_ = (e & 3) + 8 * (e >> 2); p_[e] = __builtin_amdgcn_exp2f(fminf(fmaf(sl_, (float)ce_, a_[e] + b0_), 100.f)); } } \
        _Pragma("unroll") for (int e = 0; e < 16; ++e) ls += p_[e]; \
        u32x4 w0_, w1_; w0_.x = pk2(p_[0], p_[1]); w0_.y = pk2(p_[2], p_[3]); w0_.z = pk2(p_[4], p_[5]); w0_.w = pk2(p_[6], p_[7]); \
        w1_.x = pk2(p_[8], p_[9]); w1_.y = pk2(p_[10], p_[11]); w1_.z = pk2(p_[12], p_[13]); w1_.w = pk2(p_[14], p_[15]); \
        const bf16x8 pa0_ = __builtin_bit_cast(bf16x8, w0_), pa1_ = __builtin_bit_cast(bf16x8, w1_); \
        asm volatile("s_waitcnt lgkmcnt(0)" ::: "memory"); \
        _Pragma("unroll") for (int s = 0; s < 2; ++s) _Pragma("unroll") for (int dn = 0; dn < 2; ++dn) { \
            const s16x4 t0_ = __builtin_bit_cast(s16x4, __builtin_amdgcn_ds_read_tr16_b64_v4i16((LAS s16x4*)(vb_ + troff + (16 * s) * 192 + 64 * dn))); \
            const s16x4 t1_ = __builtin_bit_cast(s16x4, __builtin_amdgcn_ds_read_tr16_b64_v4i16((LAS s16x4*)(vb_ + troff + (16 * s + 8) * 192 + 64 * dn))); \
            const bf16x8 vf_ = (bf16x8){t0_[0], t0_[1], t0_[2], t0_[3], t1_[0], t1_[1], t1_[2], t1_[3]}; \
            if (dn == 0) o0 = __builtin_amdgcn_mfma_f32_32x32x16_bf16(vf_, s == 0 ? pa0_ : pa1_, o0, 0, 0, 0);     \
            else o1 = __builtin_amdgcn_mfma_f32_32x32x16_bf16(vf_, s == 0 ? pa0_ : pa1_, o1, 0, 0, 0); } \
        if (++cj == n) {     \
            const float l_ = shx_sum<32>(ls), li_ = 1.f / l_; \
            if (hi == 0) lsel[pat * 512 + r + dil * (lq0 + r32) - 512 * sb] = ref + log2f(l_);     \
            _Pragma("unroll") for (int j_ = 0; j_ < 4; ++j_) { u32x2 wa_, wb_; \
                wa_.x = pk2(o0[4 * j_] * li_, o0[4 * j_ + 1] * li_); wa_.y = pk2(o0[4 * j_ + 2] * li_, o0[4 * j_ + 3] * li_); \
                wb_.x = pk2(o1[4 * j_] * li_, o1[4 * j_ + 1] * li_); wb_.y = pk2(o1[4 * j_ + 2] * li_, o1[4 * j_ + 3] * li_); \
                *(LAS u32x2*)(vbuf + r32 * 144 + 16 * j_ + 8 * hi) = wa_; *(LAS u32x2*)(vbuf + r32 * 144 + 64 + 16 * j_ + 8 * hi) = wb_; } \
            asm volatile("s_waitcnt lgkmcnt(0)" ::: "memory"); \
            _Pragma("unroll") for (int i_ = 0; i_ < 4; ++i_) { const int qi_ = (lane >> 3) + 8 * i_; const u32x4 v_ = *(const LAS u32x4*)(vbuf + qi_ * 144 + (lane & 7) * 16); \
                *(GAS u32x4*)(OP + ((size_t)pat * NTOK + b * 2048 + r + dil * (lq0 + qi_)) * DATT + h * 64 + (lane & 7) * 8) = v_; } \
            asm volatile("s_waitcnt lgkmcnt(0)" ::: "memory"); \
            cj = 0; if (++cit < 6) attn_qt(cit, wave, sb, pat, r, dil, lq0, n); } } while (0)
    AT_LDQ(qf, r, dil, lq0);
    AT_LOADJOB(kA, vA); AT_LOADJOB(kB, vB); AT_LOADJOB(kC, vC);
    while (cit < 6) {
        AT_COMPJOB(kA, vA); AT_LOADJOB(kA, vA); if (cit >= 6) break;
        AT_COMPJOB(kB, vB); AT_LOADJOB(kB, vB); if (cit >= 6) break;
        AT_COMPJOB(kC, vC); AT_LOADJOB(kC, vC);
    }
#undef AT_LDQ
#undef AT_LOADJOB
#undef AT_COMPJOB
    __syncthreads();
    {
        const int c = tid & 7; bf16_t* mgb = (bf16_t*)(ws + WS_MG);
#pragma unroll 2
        for (int it = 0; it < 8; ++it) { const int tok = b * 2048 + 512 * sb + 64 * it + (tid >> 3);
            const int ql = 64 * it + (tid >> 3); const float l0 = lsel[ql], l1 = lsel[512 + ql], l2 = lsel[1024 + ql];
            const u32x4 a = *(const GAS u32x4*)(OP + ((size_t)0 * NTOK + tok) * DATT + h * 64 + 8 * c), bq = *(const GAS u32x4*)(OP + ((size_t)1 * NTOK + tok) * DATT + h * 64 + 8 * c),
                        cq = *(const GAS u32x4*)(OP + ((size_t)2 * NTOK + tok) * DATT + h * 64 + 8 * c);
            const float lm = fmaxf(l0, fmaxf(l1, l2)); float w0 = exp2f(l0 - lm), w1 = exp2f(l1 - lm), w2 = exp2f(l2 - lm); const float wi = 1.f / (w0 + w1 + w2); w0 *= wi; w1 *= wi; w2 *= wi;
            float ssq = 0.f, ov[8];
#pragma unroll
            for (int e = 0; e < 4; ++e) { const float lo = w0 * bflo(a[e]) + w1 * bflo(bq[e]) + w2 * bflo(cq[e]), hv = w0 * bfhi(a[e]) + w1 * bfhi(bq[e]) + w2 * bfhi(cq[e]); ssq += lo * lo + hv * hv; ov[2 * e] = lo; ov[2 * e + 1] = hv; }
            { u32x2 o8; o8.x = pk4_fp8(ov[0], ov[1], ov[2], ov[3]); o8.y = pk4_fp8(ov[4], ov[5], ov[6], ov[7]); __hip_atomic_store((unsigned long long*)((unsigned char*)mgb + (size_t)tok * DM + 1024 + h * 64 + 8 * c), ((unsigned long long)o8.y << 32) | o8.x, __ATOMIC_RELAXED, __HIP_MEMORY_SCOPE_AGENT); }
            ssq = shx_sum<1>(ssq); ssq = shx_sum<2>(ssq); ssq = shx_sum<4>(ssq);
            if (c == 0) __hip_atomic_store((unsigned*)((float*)(ws + WS_PART) + PART_SA + (size_t)h * NTOK + tok), __builtin_bit_cast(unsigned, ssq), __ATOMIC_RELAXED, __HIP_MEMORY_SCOPE_AGENT); }
    }
    __syncthreads();
}

constexpr size_t LIST_STRIDE = 2162688;
constexpr size_t WS_LTOK = WS_LIST, WS_LW = WS_LIST + LIST_STRIDE, WS_LSLOT = WS_LIST + 2 * LIST_STRIDE;
static_assert(WS_LSLOT + LIST_STRIDE <= WS_H1, "lists");

__device__ __forceinline__ void router_prep(const float* wr, bf16_t* wrh, bf16_t* wrl, int gt, int NGT) {
    for (int i = gt; i < 64 * 256; i += NGT) { const int e = i >> 8, k0 = (i & 255) * 8; float v[8]; unsigned h[8], l[8];
#pragma unroll
        for (int j = 0; j < 8; ++j) { v[j] = wr[(size_t)(k0 + j) * 64 + e]; h[j] = f2bf(v[j]); l[j] = f2bf(v[j] - __builtin_bit_cast(float, h[j] << 16)); }
        u32x4 oh, ol; oh.x = h[0] | (h[1] << 16); oh.y = h[2] | (h[3] << 16); oh.z = h[4] | (h[5] << 16); oh.w = h[6] | (h[7] << 16);
        ol.x = l[0] | (l[1] << 16); ol.y = l[2] | (l[3] << 16); ol.z = l[4] | (l[5] << 16); ol.w = l[6] | (l[7] << 16);
        *(GAS u32x4*)(wrh + (size_t)e * DM + k0) = oh; *(GAS u32x4*)(wrl + (size_t)e * DM + k0) = ol; }
}

__device__ __forceinline__ void route_unit(const Args& args, unsigned char* ws, unsigned* ctl, LAS unsigned char* lds, int unit, int tid, int wave, int lane) {
    const int fr = lane & 15, fq = lane >> 4, tok0 = unit * 32;
    LAS f32x2* stats = (LAS f32x2*)lds;
    LAS float* part = (LAS float*)(lds + 1024);
    LAS float* sel = (LAS float*)(lds + 1024 + 65536);
    LAS float* sc = sel + 2048;
    LAS float* msk = sc + 2048;
    LAS int* lcnt = (LAS int*)(msk + 2048);
    LAS int* lbase = lcnt + 64;
    LAS int* eidx = lbase + 64;
    LAS float* ew = (LAS float*)(eidx + 256);
    LAS int* epos = (LAS int*)(ew + 256);
    const bf16_t* pre1 = (const bf16_t*)(ws + WS_PRE1);
    if (tid < 64) lcnt[tid] = 0;
    __syncthreads();
    { const float* gp = (const float*)(ws + WS_PART); const int t = tid & 31, i = tid >> 5;
      const float a0 = gp[PART_LS + (size_t)i * NTOK + tok0 + t], a1 = gp[PART_LS + (size_t)(i + 16) * NTOK + tok0 + t];
      const float q0 = gp[PART_LQ + (size_t)i * NTOK + tok0 + t], q1 = gp[PART_LQ + (size_t)(i + 16) * NTOK + tok0 + t];
      part[i * 32 + t] = a0; part[(i + 16) * 32 + t] = a1; part[(32 + i) * 32 + t] = q0; part[(48 + i) * 32 + t] = q1; }
    __syncthreads();
    if (tid < 32) { float su = 0.f, sq = 0.f;
#pragma unroll 8
        for (int i = 0; i < 32; ++i) { su += part[i * 32 + tid]; sq += part[(32 + i) * 32 + tid]; }
        const float mean = su * (1.f / DM);
        stats[tid] = (f32x2){mean, rsqrtf(fmaxf(sq * (1.f / DM) - mean * mean, 0.f) + EPS)}; }
    __syncthreads();
    {
        const bf16_t* wrh = (const bf16_t*)(ws + WS_WR); const bf16_t* wrl = wrh + 64 * DM; bf16_t* h1 = (bf16_t*)(ws + WS_H1); unsigned char* h1f = ws + WS_H1F;
        const float* g1 = args.in[14]; const float* b1 = args.in[15];
        f32x4 acc[2][4];
#pragma unroll
        for (int m = 0; m < 2; ++m)
#pragma unroll
            for (int n = 0; n < 4; ++n) acc[m][n] = (f32x4){0.f, 0.f, 0.f, 0.f};
        const f32x2 st0 = stats[fr], st1 = stats[16 + fr];
        u32x4 nx[2]; bf16x8 nwh[4], nwl[4];
#define P5_LOAD(ks_) do { const int k_ = 256 * wave + 32 * (ks_) + 8 * fq; \
            _Pragma("unroll") for (int m = 0; m < 2; ++m) { const size_t off_ = (size_t)(tok0 + 16 * m + fr) * DM + k_; nx[m] = *(const GAS u32x4*)(pre1 + off_); } \
            _Pragma("unroll") for (int n = 0; n < 4; ++n) { nwh[n] = *(const GAS bf16x8*)(wrh + (size_t)(16 * n + fr) * DM + k_); nwl[n] = *(const GAS bf16x8*)(wrl + (size_t)(16 * n + fr) * DM + k_); } } while (0)
        P5_LOAD(0);
#pragma unroll 1
        for (int ks = 0; ks < 8; ++ks) { const int k = 256 * wave + 32 * ks + 8 * fq;
            const f32x4 ga = *(const GAS f32x4*)(g1 + k), gb = *(const GAS f32x4*)(g1 + k + 4), ba = *(const GAS f32x4*)(b1 + k), bb = *(const GAS f32x4*)(b1 + k + 4); u32x4 x_[2]; bf16x8 wh_[4], wl_[4];
#pragma unroll
            for (int m = 0; m < 2; ++m) x_[m] = nx[m];
#pragma unroll
            for (int n = 0; n < 4; ++n) { wh_[n] = nwh[n]; wl_[n] = nwl[n]; }
            if (ks + 1 < 8) P5_LOAD(ks + 1);
            bf16x8 ahi[2], alo[2];
#pragma unroll
            for (int m = 0; m < 2; ++m) { const f32x2 st = m == 0 ? st0 : st1; const size_t off = (size_t)(tok0 + 16 * m + fr) * DM + k;
                const f32x4 xa = (f32x4){bflo(x_[m][0]), bfhi(x_[m][0]), bflo(x_[m][1]), bfhi(x_[m][1])}, xb = (f32x4){bflo(x_[m][2]), bfhi(x_[m][2]), bflo(x_[m][3]), bfhi(x_[m][3])};
                const f32x4 ha = (xa - st.x) * st.y * ga + ba, hb = (xb - st.x) * st.y * gb + bb;
                u32x4 oh, ol;
                oh.x = pk2(ha[0], ha[1]); oh.y = pk2(ha[2], ha[3]); oh.z = pk2(hb[0], hb[1]); oh.w = pk2(hb[2], hb[3]);
                ol.x = pk2(ha[0] - bflo(oh.x), ha[1] - bfhi(oh.x)); ol.y = pk2(ha[2] - bflo(oh.y), ha[3] - bfhi(oh.y));
                ol.z = pk2(hb[0] - bflo(oh.z), hb[1] - bfhi(oh.z)); ol.w = pk2(hb[2] - bflo(oh.w), hb[3] - bfhi(oh.w));
                { u32x2 o8; o8.x = pk4_fp8(ha[0], ha[1], ha[2], ha[3]); o8.y = pk4_fp8(hb[0], hb[1], hb[2], hb[3]); *(GAS u32x2*)(h1f + off) = o8; }
                *(GAS u32x4*)(h1 + off) = oh; ahi[m] = __builtin_bit_cast(bf16x8, oh); alo[m] = __builtin_bit_cast(bf16x8, ol); }
#pragma unroll
            for (int n = 0; n < 4; ++n) {
#pragma unroll
                for (int m = 0; m < 2; ++m) { acc[m][n] = __builtin_amdgcn_mfma_f32_16x16x32_bf16(wh_[n], ahi[m], acc[m][n], 0, 0, 0);
                    acc[m][n] = __builtin_amdgcn_mfma_f32_16x16x32_bf16(wh_[n], alo[m], acc[m][n], 0, 0, 0); acc[m][n] = __builtin_amdgcn_mfma_f32_16x16x32_bf16(wl_[n], ahi[m], acc[m][n], 0, 0, 0); } } }
#undef P5_LOAD
#pragma unroll
        for (int m = 0; m < 2; ++m)
#pragma unroll
            for (int n = 0; n < 4; ++n) *(LAS f32x4*)(part + (wave * 32 + 16 * m + fr) * 64 + 16 * n + 4 * fq) = acc[m][n];
    }
    __syncthreads();
    {
        const int i4 = tid * 4; f32x4 s = (f32x4){0.f, 0.f, 0.f, 0.f};
#pragma unroll
        for (int w = 0; w < 8; ++w) s += *(const LAS f32x4*)(part + w * 2048 + i4);
        const f32x4 bias = *(const GAS f32x4*)(args.in[17] + (i4 & 63)); f32x4 scv, sev;
#pragma unroll
        for (int j = 0; j < 4; ++j) { scv[j] = 1.f / (1.f + expf(-s[j])); sev[j] = scv[j] + bias[j]; }
        *(LAS f32x4*)(sc + i4) = scv; *(LAS f32x4*)(sel + i4) = sev;
    }
    __syncthreads();
    {
        const int e = lane, g = e >> 3, li = e & 7; float sv[4], scv[4], gs[4]; bool keep[4];
#pragma unroll
        for (int rr = 0; rr < 4; ++rr) { sv[rr] = sel[(4 * wave + rr) * 64 + e]; scv[rr] = sc[(4 * wave + rr) * 64 + e]; }
#pragma unroll
        for (int rr = 0; rr < 4; ++rr) { float m1 = sv[rr];
            m1 = shx_max<1>(m1); m1 = shx_max<2>(m1); m1 = shx_max<4>(m1);
            const unsigned long long bm = __ballot(sv[rr] == m1); const int first = __builtin_ctz((unsigned)((bm >> (g * 8)) & 0xffull));
            float m2 = (li == first) ? -INFINITY : sv[rr];
            m2 = shx_max<1>(m2); m2 = shx_max<2>(m2); m2 = shx_max<4>(m2);
            gs[rr] = m1 + m2; keep[rr] = false; }
        bool gtaken[4] = {false, false, false, false};
#pragma unroll
        for (int round = 0; round < 4; ++round)
#pragma unroll
            for (int rr = 0; rr < 4; ++rr) { const float cur = gtaken[rr] ? -INFINITY : gs[rr], mx = wave_max_f(cur);
                const unsigned long long bm = __ballot(cur == mx); const int gsel = (int)(__builtin_ctzll(bm) >> 3);
                if (g == gsel) { gtaken[rr] = true; keep[rr] = true; } }
        bool taken[4] = {false, false, false, false}; int rank[4] = {-1, -1, -1, -1};
#pragma unroll
        for (int round = 0; round < 8; ++round)
#pragma unroll
            for (int rr = 0; rr < 4; ++rr) { const float cur = (keep[rr] && !taken[rr]) ? sv[rr] : -INFINITY, mx = wave_max_f(cur);
                const unsigned long long bm = __ballot(cur == mx); const int f = (int)__builtin_ctzll(bm);
                if (e == f) { taken[rr] = true; rank[rr] = round; } }
#pragma unroll
        for (int rr = 0; rr < 4; ++rr) { const int row = 4 * wave + rr; const bool selected = rank[rr] >= 0;
            const float wsum = wave_sum_f(selected ? scv[rr] : 0.f);
            if (selected) { const int lp = __hip_atomic_fetch_add(&lcnt[e], 1, __ATOMIC_RELAXED, __HIP_MEMORY_SCOPE_WORKGROUP); eidx[row * 8 + rank[rr]] = e; ew[row * 8 + rank[rr]] = scv[rr] / wsum * 2.5f; epos[row * 8 + rank[rr]] = lp; } }
    }
    __syncthreads();
    if (tid < 64) { const int c = lcnt[tid]; lbase[tid] = c > 0 ? atomicAdd((int*)(ctl + CW_CNT) + tid, c) : 0; }
    __syncthreads();
    int* ltok = (int*)(ws + WS_LTOK); float* lw = (float*)(ws + WS_LW); int* lslot = (int*)(ws + WS_LSLOT);
    if (tid < 256) { const int row = tid >> 3, k = tid & 7, e = eidx[tid], pos = lbase[e] + epos[tid], tok = tok0 + row;
        ltok[e * CAP + pos] = tok; lw[e * CAP + pos] = ew[tid]; lslot[e * CAP + pos] = tok * 9 + k; }
    else if (tid < 288) { const int tok = tok0 + (tid - 256); ltok[NEXP * CAP + tok] = tok; lw[NEXP * CAP + tok] = 1.f; lslot[NEXP * CAP + tok] = tok * 9 + 8; }
    if (unit == 0 && tid == 300) ((int*)(ctl + CW_CNT))[NEXP] = NTOK;
    __syncthreads();
}

constexpr int MOE_DESC_OFF = MISC_OFF + 256, MOE_RTAB_OFF = MISC_OFF + 1024, MOE_TMP_OFF = MISC_OFF + 1024 + 13312;
template <int NT, bool GATHER>
__device__ __forceinline__ void moe_setup(unsigned char* ws, unsigned* ctl, LAS unsigned char* lds, int vcu, int G, int tid) {
    LAS int* desc = (LAS int*)(lds + MOE_DESC_OFF); LAS unsigned* rtab = (LAS unsigned*)(lds + MOE_RTAB_OFF); LAS int* tmp = (LAS int*)(lds + MOE_TMP_OFF);
    const int* cnt = (const int*)(ctl + CW_CNT);
    if (tid < 65) tmp[tid] = __hip_atomic_load(cnt + tid, __ATOMIC_RELAXED, __HIP_MEMORY_SCOPE_AGENT);
    if (tid < 16) desc[tid * 8] = -1;
    __syncthreads();
    if (tid < 66) { int tp = 0; for (int k = 0; k < 65; ++k) { const int mt = (tmp[k] + 255) >> 8; tp += (k < tid) ? mt : 0; } tmp[128 + tid] = tp * NT; tmp[256 + tid] = tp * 256; }
    __syncthreads();
    if (tid < 65) { const int t0 = tmp[128 + tid], t1 = tmp[128 + tid + 1], ce = tmp[tid], rb = tmp[256 + tid];
        for (int i = 0; i < 16; ++i) { const int L = i * G + vcu;
            if (L >= t0 && L < t1) { const int local = L - t0, mt = local / NT, nt = local % NT, rows = ce - mt * 256;
                desc[i * 8 + 0] = tid; desc[i * 8 + 1] = mt; desc[i * 8 + 2] = nt; desc[i * 8 + 3] = rows < 256 ? rows : 256; desc[i * 8 + 4] = rb + mt * 256; } } }
    __syncthreads();
    if (GATHER) { const int* ltok = (const int*)(ws + WS_LTOK); unsigned v[4];
#pragma unroll
        for (int q = 0; q < 4; ++q) { const int j = tid + 512 * q, i = j >> 8, e = desc[i * 8]; int tok = 0;
            if (e >= 0) { const int idx = desc[i * 8 + 1] * 256 + (j & 255); if (idx < tmp[e]) tok = ltok[e * CAP + idx]; }
            v[q] = (unsigned)tok * (unsigned)DM; }
#pragma unroll
        for (int q = 0; q < 4; ++q) rtab[tid + 512 * q] = v[q];
        __syncthreads(); }
    else { const int* lslot = (const int*)(ws + WS_LSLOT); const float* lw = (const float*)(ws + WS_LW); LAS unsigned* stab = (LAS unsigned*)(lds + MOE_RTAB_OFF); int sl[7]; float w[7];
#pragma unroll
        for (int q = 0; q < 7; ++q) { const int j = tid + 512 * q, i = j >> 8; sl[q] = -1; w[q] = 0.f;
            if (i < 13) { const int e = desc[i * 8]; if (e >= 0) { const int idx = desc[i * 8 + 1] * 256 + (j & 255); if (idx < tmp[e]) { sl[q] = lslot[e * CAP + idx]; w[q] = lw[e * CAP + idx]; } } } }
#pragma unroll
        for (int q = 0; q < 7; ++q) { const int j = tid + 512 * q; if (j < 13 * 256) stab[j] = sl[q] < 0 ? 0u : (((unsigned)sl[q] << 15) | (f2bf(w[q] * (WUNSCALE8 * YSCALE8)) & 0x7fffu)); }
        __syncthreads(); }
}
template <bool GATHER_>
struct MoeSched {
    static constexpr bool GATHER = GATHER_;
    LAS const int* desc; LAS const unsigned* rtab; const char* A; const char* Bt; unsigned lda, ldb; int nt; size_t bexp; int lo, hi;
    __device__ __forceinline__ bool next(int i_, g8::Unit& u) const {
        const int i = i_ + lo; if (i >= hi || i >= (GATHER ? 8 : 13)) return false;
        const int e = __builtin_amdgcn_readfirstlane(desc[i * 8]); if (e < 0) return false;
        u.e = e; u.pm = __builtin_amdgcn_readfirstlane(desc[i * 8 + 1]); u.pn = __builtin_amdgcn_readfirstlane(desc[i * 8 + 2]); u.rows = __builtin_amdgcn_readfirstlane(desc[i * 8 + 3]);
        u.aux = GATHER ? i : __builtin_amdgcn_readfirstlane(desc[i * 8 + 4]); u.seg = i; return true;
    }
    __device__ __forceinline__ const char* a_base(const g8::Unit& u) const { return GATHER ? A : A + (size_t)u.aux * lda; }
    __device__ __forceinline__ const char* b_base(const g8::Unit& u) const { return Bt + (size_t)u.e * bexp + (size_t)u.pn * 256 * ldb; }
    __device__ __forceinline__ void g_off(const g8::Unit& u, int r, int cb, unsigned (&v0)[2], unsigned (&v1)[2]) const {
        LAS const unsigned* t = rtab + u.aux * 256 + r;
        v0[0] = t[0] + (unsigned)cb; v0[1] = t[64] + (unsigned)cb; v1[0] = t[128] + (unsigned)cb; v1[1] = t[192] + (unsigned)cb;
    }
};
struct EpiAct {
    static constexpr bool PERM = true;
    unsigned char* act; LAS const int* desc;
    __device__ __forceinline__ bool keep(const g8::Unit&) const { return false; }
    __device__ __forceinline__ void operator()(f32x4 (&acc)[2][2][4][2], const g8::Unit& u, int wr, int wc, int fr, int fq) const {
        asm volatile("" : "+v"(fr), "+v"(fq));
        const int rb = __builtin_amdgcn_readfirstlane(desc[u.aux * 8 + 4]); const int col = u.pn * 128 + wc * 32 + 8 * fq;
#pragma unroll
        for (int ai = 0; ai < 2; ++ai)
#pragma unroll
            for (int m = 0; m < 4; ++m) { const int rl = ai * 128 + wr * 64 + m * 16 + fr;
                if (rl < u.rows) { float y[8];
#pragma unroll
                    for (int n = 0; n < 2; ++n)
#pragma unroll
                        for (int e = 0; e < 4; ++e) { const float g = acc[ai][0][m][n][e] * WUNSCALE8; y[4 * n + e] = g * sigmoid_f(g) * (acc[ai][1][m][n][e] * WUNSCALE8); }
                    u32x2 w; w.x = pk4_fp8(y[0], y[1], y[2], y[3]); w.y = pk4_fp8(y[4], y[5], y[6], y[7]);
                    *(GAS u32x2*)(act + (size_t)(rb + rl) * DEXP + col) = w; } }
    }
};
struct EpiDown {
    static constexpr int PERM = 2;
    unsigned char* y; LAS const unsigned* stab;
    __device__ __forceinline__ bool keep(const g8::Unit&) const { return false; }
    __device__ __forceinline__ void operator()(f32x4 (&acc)[2][2][4][2], const g8::Unit& u, int wr, int wc, int fr, int fq) const {
        asm volatile("" : "+v"(fr), "+v"(fq));
#pragma unroll
        for (int ai = 0; ai < 2; ++ai)
#pragma unroll
            for (int m = 0; m < 4; ++m) { const int rl = ai * 128 + wr * 64 + m * 16 + fr;
                if (rl < u.rows) { const unsigned pk_ = stab[u.seg * 256 + rl]; const float w = __builtin_bit_cast(float, (pk_ & 0x7fffu) << 16);
                    const f32x4 a0 = acc[ai][0][m][0] * w, a1 = acc[ai][0][m][1] * w, b0 = acc[ai][1][m][0] * w, b1 = acc[ai][1][m][1] * w;
                    u32x4 o; o.x = pk4_fp8(a0[0], a0[1], a0[2], a0[3]); o.y = pk4_fp8(a1[0], a1[1], a1[2], a1[3]); o.z = pk4_fp8(b0[0], b0[1], b0[2], b0[3]); o.w = pk4_fp8(b1[0], b1[1], b1[2], b1[3]);
                    *(GAS u32x4*)(y + (size_t)(pk_ >> 15) * DM + u.pn * 256 + 16 * (4 * wc + fq)) = o; } }
    }
};
__device__ __forceinline__ float fp8lo(unsigned w, int i) { return i == 0 ? __builtin_amdgcn_cvt_f32_fp8(w, 0) : i == 1 ? __builtin_amdgcn_cvt_f32_fp8(w, 1) : i == 2 ? __builtin_amdgcn_cvt_f32_fp8(w, 2) : __builtin_amdgcn_cvt_f32_fp8(w, 3); }
#define P8_LOAD(Y_, HA_, HB_, tok_, j_) do { const int col_ = 16 * lane + 1024 * (j_); _Pragma("unroll") for (int k = 0; k < 9; ++k) Y_[k] = *(const GAS u32x4*)(y + (size_t)((tok_) * 9 + k) * DM + col_); \
        HA_ = *(const GAS u32x4*)(h1 + (size_t)(tok_) * DM + col_); HB_ = *(const GAS u32x4*)(h1 + (size_t)(tok_) * DM + col_ + 8); } while (0)
#define P8_PROC(Y_, HA_, HB_, vj_) do { float a_[16]; _Pragma("unroll") for (int e = 0; e < 16; ++e) a_[e] = 0.f; \
        _Pragma("unroll") for (int k = 0; k < 9; ++k) _Pragma("unroll") for (int e = 0; e < 4; ++e) { const unsigned w_ = Y_[k][e]; a_[4 * e] += fp8lo(w_, 0); a_[4 * e + 1] += fp8lo(w_, 1); a_[4 * e + 2] += fp8lo(w_, 2); a_[4 * e + 3] += fp8lo(w_, 3); } \
        _Pragma("unroll") for (int e = 0; e < 4; ++e) { vj_[2 * e] = ALPHA * bflo(HA_[e]) + YUNSCALE8 * a_[2 * e]; vj_[2 * e + 1] = ALPHA * bfhi(HA_[e]) + YUNSCALE8 * a_[2 * e + 1]; \
            vj_[8 + 2 * e] = ALPHA * bflo(HB_[e]) + YUNSCALE8 * a_[8 + 2 * e]; vj_[8 + 2 * e + 1] = ALPHA * bfhi(HB_[e]) + YUNSCALE8 * a_[8 + 2 * e + 1]; } } while (0)
__device__ __forceinline__ void final_rows(const Args& args, unsigned char* ws, LAS unsigned char* lds, int wave, int gw, int NGW, int lane) {
    LAS float* obuf = (LAS float*)(lds + wave * 8192);
    const bf16_t* h1 = (const bf16_t*)(ws + WS_H1); const unsigned char* y = ws + WS_Y; const float* g2 = args.in[24]; const float* b2 = args.in[25];
    u32x4 ya[9], yb[9], haa, hba, hab, hbb;
    int tok = gw;
    if (tok < NTOK) P8_LOAD(ya, haa, hba, tok, 0);
    for (; tok < NTOK; tok += NGW) {
        float v0[16], v1[16];
        P8_LOAD(yb, hab, hbb, tok, 1);
        P8_PROC(ya, haa, hba, v0);
        if (tok + NGW < NTOK) P8_LOAD(ya, haa, hba, tok + NGW, 0);
        P8_PROC(yb, hab, hbb, v1);
        float s = 0.f;
#pragma unroll
        for (int e = 0; e < 16; ++e) s += v0[e] + v1[e];
        const float mean = wave_sum_f(s) * (1.f / DM); float q = 0.f;
#pragma unroll
        for (int e = 0; e < 16; ++e) { v0[e] -= mean; v1[e] -= mean; q += v0[e] * v0[e] + v1[e] * v1[e]; }
        const float rstd = rsqrtf(wave_sum_f(q) * (1.f / DM) + EPS);
#pragma unroll
        for (int j = 0; j < 2; ++j) { const int col = 16 * lane + 1024 * j;
#pragma unroll
            for (int c = 0; c < 4; ++c) { const f32x4 ga = *(const GAS f32x4*)(g2 + col + 4 * c), ba = *(const GAS f32x4*)(b2 + col + 4 * c); f32x4 o;
#pragma unroll
                for (int e = 0; e < 4; ++e) o[e] = (j == 0 ? v0[4 * c + e] : v1[4 * c + e]) * rstd * ga[e] + ba[e];
                *(LAS f32x4*)(obuf + col + 4 * c) = o; } }
        asm volatile("s_waitcnt lgkmcnt(0)" ::: "memory");
#pragma unroll
        for (int i = 0; i < 8; ++i) { const f32x4 o = *(const LAS f32x4*)(obuf + 4 * lane + 256 * i); *(GAS f32x4*)(args.out + (size_t)tok * DM + 4 * lane + 256 * i) = o; }
        asm volatile("s_waitcnt lgkmcnt(0)" ::: "memory");
    }
}
#undef P8_LOAD
#undef P8_PROC

__global__ void __launch_bounds__(NWAVES * 64, 2) mega_fwd(Args args) {
    extern __shared__ __attribute__((aligned(16))) unsigned char lds_raw[];
    Frame F;
    F.lds = (LAS unsigned char*)lds_raw; F.MISC = (volatile LAS unsigned*)(F.lds + MISC_OFF);
    F.tid = threadIdx.x; F.lane = F.tid & 63; F.wave = __builtin_amdgcn_readfirstlane(F.tid >> 6);
    F.G = gridDim.x; { const int bx = blockIdx.x; F.vcu = (F.G % 8 == 0) ? (bx % 8) * (F.G / 8) + bx / 8 : bx; }
    F.ws = args.ws; F.ctl = (unsigned*)(args.ws + WS_CTL);
    unsigned char* ws = args.ws;
    for (int u = F.tid; u < (LDS_BYTES - MISC_OFF) / 4; u += NWAVES * 64) ((LAS unsigned*)(F.lds + MISC_OFF))[u] = 0u;
    __syncthreads();
    XcdBarrier bar; bar.bar = F.ctl + CW_BAR + args.pad * XCD_BAR_WORDS; bar.x = 0; bar.st = nullptr;
    if (args.use_bar) bar = xcd_barrier_post(F.ctl + CW_BAR + args.pad * XCD_BAR_WORDS, F.MISC + 8);
    const int lo = args.ph_lo, hi = args.ph_hi;
#define IN(k) (lo <= (k) && (k) < hi)
#define SEAM(k) do { if (IN(k) && IN((k) + 1)) xcd_barrier(bar, F.wave); } while (0)
    const int gw = F.vcu * NWAVES + F.wave, NGW = F.G * NWAVES;
    const int NGT = F.G * NWAVES * 64;
#define REFRESH_TID() do { F.lane = fresh_lane(); F.tid = F.wave * 64 + F.lane; } while (0)
#define GT() ((int)blockIdx.x * (NWAVES * 64) + F.tid)

    if (IN(0)) { REFRESH_TID();
        const float* x = args.in[0];
        { bf16_t* xb = (bf16_t*)(ws + WS_XB);
#pragma unroll 4
          for (int i = GT(); i < NTOK * DM / 8; i += NGT) { const f32x4 a = *(const GAS f32x4*)(x + (size_t)i * 8), b = *(const GAS f32x4*)(x + (size_t)i * 8 + 4);
              u32x4 o; o.x = pk2(a[0], a[1]); o.y = pk2(a[2], a[3]); o.z = pk2(b[0], b[1]); o.w = pk2(b[2], b[3]); *(GAS u32x4*)(xb + (size_t)i * 8) = o; } }
        constexpr int I_IN = 32 * 64, I_GLU = 16 * 32, I_OUT = 32 * 32;
        constexpr int NITEMS = I_IN + I_GLU + I_OUT;
        LAS unsigned char* tile = F.lds + F.wave * 9216;
        for (int it = gw; it < NITEMS; it += NGW) {
            int r = it;
            if (r < I_IN) { const int kb = r / 64, nb = r % 64; transpose_item(args.in[1], NPROJ, (bf16_t*)(ws + WS_WIN), DM, kb * 64, nb * 64, nb * 64, nullptr, tile, F.lane); continue; } r -= I_IN;
            if (r < I_GLU) { const int kb = r / 32, nb = r % 32, n0 = nb * 64; const int orow = n0 < 1024 ? glu_row(n0) : glu_row(n0 - 1024) + 128;
                transpose_item(args.in[10], 2048, (bf16_t*)(ws + WS_WGLU), DSSM, kb * 64, n0, orow, nullptr, tile, F.lane); continue; } r -= I_GLU;
            { const int kb = r / 32, nb = r % 32; F8Item d; d.W = args.in[13]; d.WT8 = ws + WS_WOUT; d.N = DM; d.ldt = DM; d.k0 = kb * 64; d.n0 = nb * 64; d.orow0 = nb * 64; d.ks = kb < 16 ? args.in[11] : args.in[12] - 1024;
                f32x4 v[16]; f8_item_load(d, v, F.lane); f8_item_process(d, v, WSCALE8, tile, F.lane); }
        }
    }
    if (IN(0)) router_prep(args.in[16], (bf16_t*)(ws + WS_WR), (bf16_t*)(ws + WS_WR) + 64 * DM, GT(), NGT);
    if (IN(0)) {
        __syncthreads();
        for (int it = F.vcu; it < 256; it += F.G) ssm_prep_item(args, ws, F.lds, it >> 2, it & 3, F.tid);
    }
    SEAM(0);
    if (IN(1)) { REFRESH_TID();
        EpiIn E{(bf16_t*)(ws + WS_UG)};
        volatile LAS int* qslot = (volatile LAS int*)(F.lds + MISC_OFF + 64);
        const int slot = F.vcu % 3;
        for (int part = 0; part < 3; ++part) {
            if (part == slot) { __syncthreads(); REFRESH_TID();
                if (F.tid == 0) *qslot = (int)__hip_atomic_fetch_add(F.ctl + CW_QC, 1u, __ATOMIC_RELAXED, __HIP_MEMORY_SCOPE_AGENT);
                __syncthreads();
                const int w = __builtin_amdgcn_readfirstlane(*qslot);
                if (w < NCONV_GU) f8_convert_chunk(args, ws, F.lds, 0, w, F.wave, F.lane);
                __syncthreads(); }
            const int lo = part == 0 ? 0 : part == 1 ? (slot == 1 ? 1 : 2) : 2, hi = part == 0 ? (slot == 1 ? 1 : 2) : 2;
            if (part < 2 && lo < hi) { REFRESH_TID();
                g8::DenseSched S{(const char*)(ws + WS_XB), (const char*)(ws + WS_WIN), DM * 2, DM * 2, NTOK / 256, NPROJ / 256, 1, DM / 64, F.G, F.vcu, 0u, lo, hi};
                g8::gemm_phase(F.lds, S, E, F.wave); }
        }
    }
    SEAM(1);
    if (IN(2)) { REFRESH_TID();
        constexpr int NMIX = 512, NCONV = NCONV_GU;
        volatile LAS int* qslot = (volatile LAS int*)(F.lds + MISC_OFF + 64);
        unsigned* qM = F.ctl + CW_QM; unsigned* qC = F.ctl + CW_QC;
        const bool conv_first = (F.vcu & 31) >= 22;
        for (int pass = 0; pass < 2; ++pass) {
            const bool do_conv = (pass == 0) == conv_first;
            for (;;) {
                __syncthreads();
                REFRESH_TID();
                if (F.tid == 0) *qslot = (int)__hip_atomic_fetch_add(do_conv ? qC : qM, 1u, __ATOMIC_RELAXED, __HIP_MEMORY_SCOPE_AGENT);
                __syncthreads();
                const int w = __builtin_amdgcn_readfirstlane(*qslot);
                if (w >= (do_conv ? NCONV : NMIX)) break;
                if (do_conv) {
                    f8_convert_chunk(args, ws, F.lds, 0, w, F.wave, F.lane);
                } else if (w < 256) {
                    ssm_unit(ws, F.lds, w >> 6, w & 63, F.tid, F.wave, F.lane);
                    asm volatile("s_waitcnt vmcnt(0)" ::: "memory"); __syncthreads();
                    if (F.tid == 0) (void)__hip_atomic_fetch_add(F.ctl + CW_SSMDONE, 1u, __ATOMIC_RELAXED, __HIP_MEMORY_SCOPE_AGENT);
                } else { const int bh = (w - 256) >> 2, sb = (w - 256) & 3;
                    attn_unit(ws, F.ctl, F.lds, bh, sb, F.tid, F.wave, F.lane);
                    asm volatile("s_waitcnt vmcnt(0)" ::: "memory"); __syncthreads();
                    if (F.tid == 0) (void)__hip_atomic_fetch_add(F.ctl + CW_CA + (bh >> 4) * 4 + sb, 1u, __ATOMIC_RELAXED, __HIP_MEMORY_SCOPE_AGENT); }
            }
        }
        { EpiGlu E{(bf16_t*)(ws + WS_MG), (float*)(ws + WS_PART) + PART_SS}; bool acquired = false;
          for (;;) {
              __syncthreads(); REFRESH_TID();
              if (F.tid == 0) *qslot = (int)__hip_atomic_fetch_add(F.ctl + CW_Q3, 1u, __ATOMIC_RELAXED, __HIP_MEMORY_SCOPE_AGENT);
              __syncthreads();
              const int t3 = __builtin_amdgcn_readfirstlane(*qslot);
              if (t3 >= 256) break;
              if (!acquired) {
                  if (F.tid == 0) { unsigned sp = 0; while (__hip_atomic_load(F.ctl + CW_SSMDONE, __ATOMIC_RELAXED, __HIP_MEMORY_SCOPE_AGENT) < 256u) { __builtin_amdgcn_s_sleep(8); if (++sp > (1u << 22)) break; }
                      __builtin_amdgcn_fence(__ATOMIC_ACQUIRE, "agent"); asm volatile("s_waitcnt vmcnt(0)" ::: "memory"); }
                  __syncthreads(); acquired = true; }
              g8::DenseSched S{(const char*)(ws + WS_GY), (const char*)(ws + WS_WGLU), DSSM * 2, DSSM * 2, NTOK / 256, 2048 / 256, 1, DSSM / 64, F.G, t3, 0u, 0, 1};
              g8::gemm_phase(F.lds, S, E, F.wave);
              { g8::Unit u3; (void)S.next(0, u3); if (F.tid == 0) (void)__hip_atomic_fetch_add(F.ctl + CW_C3 + u3.pm, 1u, __ATOMIC_RELAXED, __HIP_MEMORY_SCOPE_AGENT); }
          } }
        { LAS int* rpm = (LAS int*)(F.lds + MISC_OFF + 128);
          EpiOut E{args.in[0], (bf16_t*)(ws + WS_PRE1), (const float*)(ws + WS_PART), (float*)(ws + WS_PART), (LAS f32x2*)(F.lds + MISC_OFF + 1024), rpm};
          for (;;) {
              __syncthreads(); REFRESH_TID();
              if (F.tid == 0) *qslot = (int)__hip_atomic_fetch_add(F.ctl + CW_Q4, 1u, __ATOMIC_RELAXED, __HIP_MEMORY_SCOPE_AGENT);
              __syncthreads();
              const int t4 = __builtin_amdgcn_readfirstlane(*qslot);
              if (t4 >= 256) break;
              g8::DenseSched S{(const char*)(ws + WS_MG), (const char*)(ws + WS_WOUT), DM, DM, NTOK / 256, DM / 256, 2, 1024 / 128, F.G, t4, 1024u, 0, 2};
              g8::Unit u0; (void)S.next(0, u0); const int pm0 = u0.pm;
              if (F.tid == 0) { unsigned sp = 0; const int ca = (pm0 >> 3) * 4 + ((pm0 & 7) >> 1);
                  while (__hip_atomic_load(F.ctl + CW_C3 + pm0, __ATOMIC_RELAXED, __HIP_MEMORY_SCOPE_AGENT) < 8u || __hip_atomic_load(F.ctl + CW_CA + ca, __ATOMIC_RELAXED, __HIP_MEMORY_SCOPE_AGENT) < 16u) { __builtin_amdgcn_s_sleep(8); if (++sp > (1u << 22)) break; }
                  __builtin_amdgcn_fence(__ATOMIC_ACQUIRE, "agent"); asm volatile("s_waitcnt vmcnt(0)" ::: "memory"); }
              __syncthreads();
              { const int row = F.tid & 255, h = F.tid >> 8; const float* part = (const float*)(ws + WS_PART) + (size_t)pm0 * 256 + row; float s = 0.f;
                if (h == 0) {
#pragma unroll
                    for (int i = 0; i < 32; ++i) s += part[PART_SS + (size_t)i * NTOK]; }
                else {
#pragma unroll
                    for (int i = 0; i < 16; ++i) s += part[PART_SA + (size_t)i * NTOK]; }
                ((LAS float*)(F.lds + MISC_OFF + 1024))[row * 2 + h] = rsqrtf(s * (1.f / 1024.f) + EPS);
                if (F.tid == 0) *rpm = pm0; __syncthreads(); }
              g8::gemm_phase_f8(F.lds, S, E, F.wave);
          } }
    }

    SEAM(4);
    if (IN(5)) { REFRESH_TID(); for (int u = F.vcu; u < 256; u += F.G) route_unit(args, ws, F.ctl, F.lds, u, F.tid, F.wave, F.lane); }
    SEAM(5);
    if (IN(6)) { REFRESH_TID();
        moe_setup<4, true>(ws, F.ctl, F.lds, F.vcu, F.G, F.tid);
        EpiAct E{ws + WS_ACT, (LAS const int*)(F.lds + MOE_DESC_OFF)};
        volatile LAS int* qslot = (volatile LAS int*)(F.lds + MISC_OFF + 64);
        int nun, quota, slot;
        { LAS const int* desc = (LAS const int*)(F.lds + MOE_DESC_OFF); LAS const int* tmp = (LAS const int*)(F.lds + MOE_TMP_OFF);
          int n_ = 0; for (int i = 0; i < 8; ++i) n_ += (desc[i * 8] >= 0) ? 1 : 0;
          nun = __builtin_amdgcn_readfirstlane(n_);
          const int bal = (tmp[128 + 65] + NCONV_D + F.G / 2) / F.G; quota = __builtin_amdgcn_readfirstlane(bal - nun); slot = F.vcu % (nun + 1); }
        for (int part = 0; part < 2; ++part) {
            const int lo = part == 0 ? 0 : slot, hi = part == 0 ? slot : nun;
            if (lo < hi) { REFRESH_TID();
                MoeSched<true> S{(LAS const int*)(F.lds + MOE_DESC_OFF), (LAS const unsigned*)(F.lds + MOE_RTAB_OFF), (const char*)(ws + WS_H1F), (const char*)(ws + WS_WGU), DM, DM, DM / 128, (size_t)1024 * DM, lo, hi};
                g8::gemm_phase_f8(F.lds, S, E, F.wave); }
            if (part == 0) { REFRESH_TID();
                for (; quota > 0; --quota) { __syncthreads();
                    if (F.tid == 0) *qslot = (int)__hip_atomic_fetch_add(F.ctl + CW_QD, 8u, __ATOMIC_RELAXED, __HIP_MEMORY_SCOPE_AGENT);
                    __syncthreads();
                    const int w = __builtin_amdgcn_readfirstlane(*qslot); if (w >= NSUB_D) break;
                    if (w + F.wave < NSUB_D) f8_convert_items(args, ws, F.lds, 1, (w + F.wave) * 8, F.wave, F.lane); }
                __syncthreads(); }
        }
        { REFRESH_TID();
          for (;;) { __syncthreads();
              if (F.tid == 0) *qslot = (int)__hip_atomic_fetch_add(F.ctl + CW_QD, 1u, __ATOMIC_RELAXED, __HIP_MEMORY_SCOPE_AGENT);
              __syncthreads();
              const int w = __builtin_amdgcn_readfirstlane(*qslot); if (w >= NSUB_D) break;
              f8_convert_one(args, ws, F.lds, 1, w * 8 + F.wave, F.wave, F.lane); } }
    }
    SEAM(6);
    if (IN(7)) { REFRESH_TID();
        moe_setup<8, false>(ws, F.ctl, F.lds, F.vcu, F.G, F.tid);
        MoeSched<false> S{(LAS const int*)(F.lds + MOE_DESC_OFF), (LAS const unsigned*)(F.lds + MOE_RTAB_OFF), (const char*)(ws + WS_ACT), (const char*)(ws + WS_WD), DEXP, DEXP, DEXP / 128, (size_t)DM * DEXP, 0, 13};
        EpiDown E{ws + WS_Y, (LAS const unsigned*)(F.lds + MOE_RTAB_OFF)};
        g8::gemm_phase_f8(F.lds, S, E, F.wave);
    }
    SEAM(7);
    if (IN(8)) { REFRESH_TID(); final_rows(args, ws, F.lds, F.wave, gw, NGW, F.lane); }
#undef IN
#undef SEAM
}

static int g_grid = 0;
static void launch_mega(void* const* d_in, void* d_out, void* d_ws, size_t ws_size, hipStream_t stream, int lo, int hi, int use_bar, int region = 0) {
    if (g_grid == 0) {
        int dev = 0, cus = 0, per_cu = 0;
        (void)hipGetDevice(&dev); (void)hipDeviceGetAttribute(&cus, hipDeviceAttributeMultiprocessorCount, dev);
        if (hipFuncSetAttribute((const void*)mega_fwd, hipFuncAttributeMaxDynamicSharedMemorySize, LDS_BYTES) != hipSuccess) { fprintf(stderr, "hipFuncSetAttribute failed\n"); g_grid = -1; return; }
        if (hipOccupancyMaxActiveBlocksPerMultiprocessor(&per_cu, (const void*)mega_fwd, NWAVES * 64, LDS_BYTES) != hipSuccess || per_cu < 1) { fprintf(stderr, "occupancy query: %d blocks/CU\n", per_cu); (void)hipGetLastError(); g_grid = -1; return; }
        g_grid = cus;
        if (ws_size < WS_END) { fprintf(stderr, "workspace too small: %zu < %zu\n", ws_size, (size_t)WS_END); g_grid = -1; return; }
    }
    if (g_grid < 0) return;
    Args a{};
    for (int i = 0; i < 26; ++i) a.in[i] = (const float*)d_in[i];
    a.out = (float*)d_out; a.ws = (unsigned char*)d_ws; a.ph_lo = lo; a.ph_hi = hi; a.use_bar = use_bar; a.pad = region;
    hipLaunchKernelGGL(mega_fwd, dim3(g_grid), dim3(NWAVES * 64), LDS_BYTES, stream, a);
}

extern "C" void kernel_launch(void* const* d_in, const int* in_sizes, int n_in, void* d_out, int out_size, void* d_ws, size_t ws_size, hipStream_t stream) {
    (void)in_sizes; (void)n_in; (void)out_size;
    (void)hipMemsetAsync((char*)d_ws + WS_CTL, 0, CTL_ZERO_BYTES, stream);
    launch_mega(d_in, d_out, d_ws, ws_size, stream, 0, 9, 1);
}
```
